# Optimizing an MI355X kernel written in HIP

```python
import math
import jax, jax.numpy as jnp
from jax import lax
import numpy as np

D_MODEL = 1024
BATCH = 8
SEQ = 4096
DEPTH = 1

LRU_WIDTH = 1024
LRU_HEADS = 16
LRU_HEAD_DIM = LRU_WIDTH // LRU_HEADS
LRU_CONV = 4
LRU_C = 8.0
HYENA_WIDTH = 1024
HYENA_ORDER = 2
HYENA_CONV = 3
FILTER_EMB = 33
FILTER_BANDS = (FILTER_EMB - 1) // 2
FILTER_HIDDEN = 64
DECAY_FAST = 0.3
DECAY_SLOW = 1.5
DECAY_TARGET = 1e-2
N_BRANCHES = 2
IN_COLS = 2 * LRU_WIDTH + (HYENA_ORDER + 1) * HYENA_WIDTH + N_BRANCHES * D_MODEL
N_EXPERTS = 16
CAPACITY_FACTOR = 2
D_FF_EXPERT = 2 * D_MODEL
EPS = 1e-6

kernel_name = "hybrid_rglru_hyena_ecmoe_encoder"


def rmsnorm(x, g):
    xf = x.astype(jnp.float32)
    y = xf * lax.rsqrt(jnp.mean(xf * xf, axis=-1, keepdims=True) + EPS)
    return (y * g.astype(jnp.float32)).astype(x.dtype)


def dwconv(x, w, b, pad):
    C = x.shape[-1]
    y = lax.conv_general_dilated(x, w[:, None, :].astype(x.dtype), window_strides=(1,), padding=[pad],
                                 dimension_numbers=("NWC", "WIO", "NWC"), feature_group_count=C)
    return y + b.astype(x.dtype)


def rg_lru(xa, w_r, b_r, w_i, b_i, lam, reverse):
    B, S, W = xa.shape
    xh = xa.reshape(B, S, LRU_HEADS, LRU_HEAD_DIM)
    r = jax.nn.sigmoid(jnp.einsum('bshi,hij->bshj', xh, w_r.astype(jnp.float32)).reshape(B, S, W) + b_r.astype(jnp.float32))
    i = jax.nn.sigmoid(jnp.einsum('bshi,hij->bshj', xh, w_i.astype(jnp.float32)).reshape(B, S, W) + b_i.astype(jnp.float32))
    log_a = -LRU_C * r * jax.nn.softplus(-lam.astype(jnp.float32))
    a = jnp.exp(log_a)
    mult = jnp.sqrt(jnp.maximum(1.0 - jnp.exp(2.0 * log_a), 0.0))
    pos = jnp.arange(S)[None, :, None]
    start = S - 1 if reverse else 0
    mult = jnp.where(pos == start, 1.0, mult)
    bx = mult * (i * xa)

    def combine(e1, e2):
        a1, b1 = e1
        a2, b2 = e2
        return a1 * a2, a2 * b1 + b2

    _, h = lax.associative_scan(combine, (a, bx), axis=1, reverse=reverse)
    return h


def hyena_filters(L, w1, b1, w2, b2, w3, freq):
    f32 = jnp.float32
    t = jnp.linspace(0.0, 1.0, L, dtype=f32)[:, None]
    w = (2.0 * math.pi / L) * jnp.arange(L, dtype=f32)[:, None]
    f = jnp.linspace(1e-4, FILTER_BANDS - 1, FILTER_BANDS, dtype=f32)[None, :]
    z = jnp.concatenate([t, jnp.cos(w * f), -jnp.sin(w * f)], axis=-1)
    freq = freq.astype(f32)
    h = jnp.sin(freq[0] * (z @ w1.astype(f32) + b1.astype(f32)))
    h = jnp.sin(freq[1] * (h @ w2.astype(f32) + b2.astype(f32)))
    h = (h @ w3.astype(f32)).reshape(L, HYENA_ORDER, 2, HYENA_WIDTH)
    min_decay = math.log(DECAY_TARGET) / DECAY_SLOW
    max_decay = math.log(DECAY_TARGET) / DECAY_FAST
    deltas = jnp.abs(jnp.linspace(min_decay, max_decay, HYENA_WIDTH, dtype=f32))
    decay = jnp.exp(-t * deltas[None, :])
    return h * decay[:, None, None, :]


def bidir_kernel(hf, hb):
    zero = jnp.zeros((1, hf.shape[1]), hf.dtype)
    return jnp.concatenate([hf, zero, hb[:0:-1]], axis=0)


def fftconv(u, k, bias):
    L = u.shape[1]
    U = jnp.fft.rfft(u, n=2 * L, axis=1)
    K = jnp.fft.rfft(k, axis=0)
    y = jnp.fft.irfft(U * K[None], n=2 * L, axis=1)[:, :L]
    return y + u * bias.astype(jnp.float32)


def setup_inputs(seed: int = 0) -> dict:
    key = jax.random.key(seed)
    ks = jax.random.split(key, 32)
    f32 = jnp.float32
    nrm = lambda k, shape, s: (jax.random.normal(k, shape, f32) * s).astype(f32)
    Dp = DEPTH
    u = jax.random.uniform(ks[9], (Dp, 2, LRU_WIDTH), f32, 0.9, 0.999)
    a0 = u ** (1.0 / LRU_C)
    lam = jnp.log(a0) - jnp.log1p(-a0)
    return {
        "x": nrm(ks[0], (BATCH, SEQ, D_MODEL), 1.0),
        "g_mix": 1.0 + nrm(ks[1], (Dp, D_MODEL), 0.01),
        "w_in": nrm(ks[2], (Dp, D_MODEL, IN_COLS), D_MODEL ** -0.5),
        "conv_a_w": nrm(ks[3], (Dp, LRU_CONV, LRU_WIDTH), LRU_CONV ** -0.5),
        "conv_a_b": nrm(ks[4], (Dp, LRU_WIDTH), 0.01),
        "lru_w_r": nrm(ks[5], (Dp, 2, LRU_HEADS, LRU_HEAD_DIM, LRU_HEAD_DIM), LRU_HEAD_DIM ** -0.5),
        "lru_b_r": nrm(ks[6], (Dp, 2, LRU_WIDTH), 0.01),
        "lru_w_i": nrm(ks[7], (Dp, 2, LRU_HEADS, LRU_HEAD_DIM, LRU_HEAD_DIM), LRU_HEAD_DIM ** -0.5),
        "lru_b_i": nrm(ks[8], (Dp, 2, LRU_WIDTH), 0.01),
        "lru_lambda": lam,
        "w_a_out": nrm(ks[10], (Dp, LRU_WIDTH, D_MODEL), LRU_WIDTH ** -0.5),
        "conv_b_w": nrm(ks[11], (Dp, HYENA_CONV, (HYENA_ORDER + 1) * HYENA_WIDTH), HYENA_CONV ** -0.5),
        "conv_b_b": nrm(ks[12], (Dp, (HYENA_ORDER + 1) * HYENA_WIDTH), 0.01),
        "filt_w1": nrm(ks[13], (Dp, FILTER_EMB, FILTER_HIDDEN), FILTER_EMB ** -0.5),
        "filt_b1": nrm(ks[14], (Dp, FILTER_HIDDEN), 0.1),
        "filt_w2": nrm(ks[15], (Dp, FILTER_HIDDEN, FILTER_HIDDEN), FILTER_HIDDEN ** -0.5),
        "filt_b2": nrm(ks[16], (Dp, FILTER_HIDDEN), 0.1),
        "filt_w3": nrm(ks[17], (Dp, FILTER_HIDDEN, HYENA_ORDER * 2 * HYENA_WIDTH), 0.005),
        "filt_freq": 1.0 + nrm(ks[18], (Dp, 2, FILTER_HIDDEN), 0.01),
        "filt_bias": nrm(ks[19], (Dp, HYENA_ORDER, HYENA_WIDTH), 0.5),
        "w_b_out": nrm(ks[20], (Dp, HYENA_WIDTH, D_MODEL), HYENA_WIDTH ** -0.5),
        "w_o": nrm(ks[21], (Dp, D_MODEL, D_MODEL), D_MODEL ** -0.5),
        "g_ffn": 1.0 + nrm(ks[22], (Dp, D_MODEL), 0.01),
        "w_router": nrm(ks[23], (Dp, D_MODEL, N_EXPERTS), D_MODEL ** -0.5),
        "w_gate": nrm(ks[24], (Dp, N_EXPERTS, D_MODEL, D_FF_EXPERT), D_MODEL ** -0.5),
        "w_up": nrm(ks[25], (Dp, N_EXPERTS, D_MODEL, D_FF_EXPERT), D_MODEL ** -0.5),
        "w_down": nrm(ks[26], (Dp, N_EXPERTS, D_FF_EXPERT, D_MODEL), D_FF_EXPERT ** -0.5),
        "g_final": 1.0 + nrm(ks[27], (D_MODEL,), 0.01),
    }


def reference(x, g_mix, w_in, conv_a_w, conv_a_b, lru_w_r, lru_b_r, lru_w_i, lru_b_i, lru_lambda, w_a_out,
              conv_b_w, conv_b_b, filt_w1, filt_b1, filt_w2, filt_b2, filt_w3, filt_freq, filt_bias, w_b_out,
              w_o, g_ffn, w_router, w_gate, w_up, w_down, g_final):
    f32 = jnp.float32
    dt = x.dtype
    B, S, D = x.shape
    bidx = jnp.arange(B)[:, None, None]
    cap = CAPACITY_FACTOR * S // N_EXPERTS
    for l in range(DEPTH):
        h = rmsnorm(x, g_mix[l])
        proj = h @ w_in[l]
        a_x, a_gate, hy, gates = jnp.split(
            proj, [LRU_WIDTH, 2 * LRU_WIDTH, 2 * LRU_WIDTH + (HYENA_ORDER + 1) * HYENA_WIDTH], axis=-1)

        xa = dwconv(a_x, conv_a_w[l], conv_a_b[l], (LRU_CONV // 2, LRU_CONV - 1 - LRU_CONV // 2)).astype(f32)
        h_a = (rg_lru(xa, lru_w_r[l, 0], lru_b_r[l, 0], lru_w_i[l, 0], lru_b_i[l, 0], lru_lambda[l, 0], False)
               + rg_lru(xa, lru_w_r[l, 1], lru_b_r[l, 1], lru_w_i[l, 1], lru_b_i[l, 1], lru_lambda[l, 1], True))
        y_a = (h_a * jax.nn.gelu(a_gate.astype(f32))).astype(dt) @ w_a_out[l]

        hy = dwconv(hy, conv_b_w[l], conv_b_b[l], (HYENA_CONV // 2, HYENA_CONV - 1 - HYENA_CONV // 2))
        v, x1, x2 = jnp.split(hy, HYENA_ORDER + 1, axis=-1)
        filt = hyena_filters(S, filt_w1[l], filt_b1[l], filt_w2[l], filt_b2[l], filt_w3[l], filt_freq[l])
        z = v.astype(f32)
        for n, gate in enumerate((x1, x2)):
            k = bidir_kernel(filt[:, n, 0], filt[:, n, 1])
            z = gate.astype(f32) * fftconv(z, k, filt_bias[l, n])
        y_b = z.astype(dt) @ w_b_out[l]

        g_a, g_b = jnp.split(jax.nn.sigmoid(gates.astype(f32)), N_BRANCHES, axis=-1)
        merged = (g_a * y_a.astype(f32) + g_b * y_b.astype(f32)).astype(dt)
        x = x + merged @ w_o[l]

        h = rmsnorm(x, g_ffn[l])
        aff = jax.nn.softmax((h @ w_router[l]).astype(f32), axis=-1)
        vals, idx = lax.top_k(jnp.swapaxes(aff, 1, 2), cap)
        xe = h[bidx, idx]
        gt = jnp.einsum('becd,edf->becf', xe, w_gate[l])
        up = jnp.einsum('becd,edf->becf', xe, w_up[l])
        ye = jnp.einsum('becf,efd->becd', jax.nn.silu(gt) * up, w_down[l])
        ye = ye * vals[..., None].astype(ye.dtype)
        x = x + jnp.zeros_like(x).at[bidx, idx].add(ye.astype(dt))
    return rmsnorm(x, g_final)
```

```cpp
#include <hip/hip_runtime.h>
#include <cstdio>
#include <cstdint>

#ifndef EPI_REPS
#define EPI_REPS 1
#endif
#ifndef REPEAT_MASK
#define REPEAT_MASK 0
#endif
#define REPS(k) (1 + ((REPEAT_MASK >> (k)) & 1))
#define LAS __attribute__((address_space(3)))
#define GAS __attribute__((address_space(1)))
typedef unsigned short bf16_t;
typedef short bf16x8 __attribute__((ext_vector_type(8)));
typedef float f32x2 __attribute__((ext_vector_type(2)));
typedef int i32x4 __attribute__((ext_vector_type(4)));
typedef int i32x8 __attribute__((ext_vector_type(8)));
typedef float f32x4 __attribute__((ext_vector_type(4)));
typedef float f32x16 __attribute__((ext_vector_type(16)));
typedef unsigned u32x2 __attribute__((ext_vector_type(2)));
typedef unsigned u32x4 __attribute__((ext_vector_type(4)));

constexpr int NB = 8, SEQ = 4096, NT = NB * SEQ, DM = 1024, NEXP = 16, CAP = 512, DFF = 2048;
constexpr int INCOLS = 7168;
constexpr float EPS = 1e-6f;
constexpr int NWAVES = 8, NTHREADS = 512;

constexpr size_t MiB = 1u << 20;
constexpr size_t WS_CTL = 0, CTL_BYTES = 1 * MiB;
constexpr size_t WS_XB = 1 * MiB;
constexpr size_t WS_WINT = 65 * MiB;
constexpr size_t WS_WA = 79 * MiB, WS_WB = 81 * MiB, WS_WO = 83 * MiB;
constexpr size_t WS_FG = 85 * MiB;
constexpr size_t WS_AX = 117 * MiB;
constexpr size_t WS_GG = 181 * MiB;
constexpr size_t WS_HYT = 245 * MiB;
constexpr size_t WS_AGG = 437 * MiB;
constexpr size_t WS_GAGG = 453 * MiB;
constexpr size_t WS_RSTD1 = 455 * MiB;
constexpr size_t WS_H2 = 1 * MiB;
constexpr size_t WS_WD = 65 * MiB;
constexpr size_t WS_WGU = 129 * MiB;
constexpr size_t WS_ACT = 257 * MiB;
constexpr size_t WS_XMID = 385 * MiB;
constexpr size_t WS_AFF = 513 * MiB;
constexpr size_t WS_TOK = 515 * MiB;
constexpr size_t WS_VAL = 515 * MiB + 256 * 1024;
constexpr size_t WS_SLOT = 516 * MiB;
constexpr size_t WS_END = 520 * MiB;

constexpr int LDS_STAGE = 131072;
constexpr int LDS_MISC = 163840 - 1024;
constexpr int LDS_BYTES = 163840;

__device__ __forceinline__ unsigned f2bf(float f) { unsigned u = __builtin_bit_cast(unsigned, f); return (u + 0x7fffu + ((u >> 16) & 1u)) >> 16; }
__device__ __forceinline__ unsigned pk2(float lo, float hi) { return f2bf(lo) | (f2bf(hi) << 16); }
__device__ __forceinline__ float bf2f(unsigned b) { return __builtin_bit_cast(float, b << 16); }
__device__ __forceinline__ float bflo(unsigned w) { return __builtin_bit_cast(float, w << 16); }
__device__ __forceinline__ float bfhi(unsigned w) { return __builtin_bit_cast(float, w & 0xffff0000u); }
__device__ __forceinline__ unsigned cvt_pk_bf16(float lo, float hi) { unsigned r; asm volatile("v_cvt_pk_bf16_f32 %0, %1, %2" : "=v"(r) : "v"(lo), "v"(hi)); return r; }
__device__ __forceinline__ float wave_sum(float v) {
#pragma unroll
    for (int o = 1; o < 64; o <<= 1) v += __shfl_xor(v, o);
    return v;
}
__device__ __forceinline__ float fast_exp(float x) { return __builtin_amdgcn_exp2f(x * 1.44269504089f); }
__device__ __forceinline__ float fast_rcp(float x) { return __builtin_amdgcn_rcpf(x); }
__device__ __forceinline__ float sigmoidf_(float x) { return fast_rcp(1.0f + fast_exp(-x)); }
__device__ __forceinline__ float gelu_tanh(float x) {
    const float u = 1.5957691216f * (x + 0.044715f * x * x * x);
    return x * sigmoidf_(u);
}
#define LDS_WAIT() asm volatile("s_waitcnt lgkmcnt(0)" ::: "memory")
#define LDS_ORDER() asm volatile("" ::: "memory")
#define VM_WAIT() asm volatile("s_waitcnt vmcnt(0)" ::: "memory")

#define XB_TMO      128
#define XB_XCNT(j)  (256  + 64 * (j))
#define XB_XSUB(j)  (1280 + 64 * (j))
#define XB_XGEN(j)  (2304 + 64 * (j))
#define XB_TOP      3328
#define XB_TOPGEN   3392
#define XCD_BAR_WORDS 3456
#define XB_SPIN_CAP (1u << 20)
__device__ __forceinline__ unsigned xb_ld(unsigned* p)              { return __hip_atomic_load(p, __ATOMIC_RELAXED, __HIP_MEMORY_SCOPE_AGENT); }
__device__ __forceinline__ unsigned xb_add(unsigned* p, unsigned v) { return __hip_atomic_fetch_add(p, v, __ATOMIC_RELAXED, __HIP_MEMORY_SCOPE_AGENT); }
__device__ __forceinline__ unsigned xb_xcc_id() { return (unsigned)__builtin_amdgcn_s_getreg((3 << 11) | 20) & 0xFu; }
#define XB_SPIN(cond, bar) do { unsigned _sp = 0; while (cond) { __builtin_amdgcn_s_sleep(1); \
    if ((++_sp & 255u) == 0u) { if (xb_ld(&(bar)[XB_TMO])) break; if (_sp > XB_SPIN_CAP) { atomicAdd(&(bar)[XB_TMO], 1u); break; } } } } while (0)
struct XcdBarrier { unsigned* bar; unsigned x; volatile LAS unsigned* st; };
__device__ __forceinline__ XcdBarrier xcd_barrier_post(unsigned* bar, volatile LAS unsigned* st) {
    XcdBarrier b; b.bar = bar; b.x = xb_xcc_id(); b.st = st;
    if (threadIdx.x == 0) (void)xb_add(&bar[XB_XCNT(b.x)], 1u);
    return b;
}
__device__ __forceinline__ void xcd_barrier_complete(unsigned* bar, unsigned x, unsigned& nloc, unsigned& nx, unsigned& xmask) {
    const unsigned G = gridDim.x * gridDim.y * gridDim.z;
    unsigned sum, cnt, mine, msk, sp = 0u;
    for (;;) {
        sum = 0u; cnt = 0u; mine = 0u; msk = 0u;
#pragma unroll
        for (unsigned j = 0; j < 16; ++j) { const unsigned c = xb_ld(&bar[XB_XCNT(j)]); sum += c; cnt += (c > 0u) ? 1u : 0u; msk |= (c > 0u) ? (1u << j) : 0u; mine = (j == x) ? c : mine; }
        if (sum == G) break;
        __builtin_amdgcn_s_sleep(1);
        if ((++sp & 255u) == 0u) { if (xb_ld(&bar[XB_TMO])) break; if (sp > XB_SPIN_CAP) { atomicAdd(&bar[XB_TMO], 1u); break; } }
    }
    nloc = mine > 0u ? mine : 1u; nx = cnt > 0u ? cnt : 1u; xmask = msk;
}
__device__ __forceinline__ void xcd_barrier(const XcdBarrier& b) {
    asm volatile("s_waitcnt vmcnt(0)" ::: "memory");
    __syncthreads();
    if (threadIdx.x == 0) {
        unsigned* bar = b.bar;
        __builtin_amdgcn_s_waitcnt(0);
        unsigned nloc = b.st[0], nx = b.st[1], xmask = b.st[2];
        if (nloc == 0u) { xcd_barrier_complete(bar, b.x, nloc, nx, xmask); b.st[0] = nloc; b.st[1] = nx; b.st[2] = xmask; }
        const unsigned old = xb_add(&bar[XB_XSUB(b.x)], 1u);
        const unsigned gen = old / nloc;
        if (old + 1u == (gen + 1u) * nloc) {
            __builtin_amdgcn_fence(__ATOMIC_RELEASE, "agent");
            asm volatile("s_waitcnt vmcnt(0)" ::: "memory");
            const unsigned og = xb_add(&bar[XB_TOP], 1u);
            const unsigned tg = og / nx;
            if (og + 1u == (tg + 1u) * nx) {
#pragma unroll
                for (unsigned j = 0; j < 16; ++j) if ((xmask >> j) & 1u) (void)xb_add(&bar[XB_XGEN(j)], 1u);
            }
            XB_SPIN(xb_ld(&bar[XB_XGEN(b.x)]) == gen, bar);
            __builtin_amdgcn_fence(__ATOMIC_ACQUIRE, "agent");
            asm volatile("s_waitcnt vmcnt(0)" ::: "memory");
        } else {
            XB_SPIN(xb_ld(&bar[XB_XGEN(b.x)]) == gen, bar);
            __builtin_amdgcn_fence(__ATOMIC_ACQUIRE, "agent");
            asm volatile("s_waitcnt vmcnt(0)" ::: "memory");
        }
    }
    __syncthreads();
}

namespace pg8 {
constexpr int BM = 256, BK = 64, HALF = 128, HTB = HALF * BK * 2, STAGE_BYTES = 8 * HTB, NXCD = 8, WGM = 8;
__device__ __forceinline__ int lds_byte(int r, int c) { const int st = (r >> 4) * 2 + (c >> 5), rr = r & 15, cc = c & 31, ob = rr * 64 + cc * 2; return st * 1024 + (ob ^ (((ob >> 9) & 1) << 5)); }
__device__ __forceinline__ void stage_rc(int b, int& R, int& C) { const int st = b / 1024, sb = b % 1024, swz = sb ^ (((sb >> 9) & 1) << 5); R = (st >> 1) * 16 + swz / 64; C = (st & 1) * 32 + (swz % 64) / 2; }
__device__ __forceinline__ int perm32(int rho) { const int n = rho >> 4, i = rho & 15; return 8 * (i >> 2) + 4 * n + (i & 3); }
struct Unit { int pm, pn, g; };
struct Pre { f32x4 a, b, c, d; };
__device__ __forceinline__ i32x8 cat8(bf16x8 a, bf16x8 b) { return __builtin_shufflevector(__builtin_bit_cast(i32x4, a), __builtin_bit_cast(i32x4, b), 0, 1, 2, 3, 4, 5, 6, 7); }
__device__ __forceinline__ void mfma_f8(f32x4& acc, i32x8 a, i32x8 b, int sc) {
    asm volatile("v_mfma_scale_f32_16x16x128_f8f6f4 %0, %1, %2, %0, %3, %3 op_sel_hi:[0,0,0]" : "+v"(acc) : "v"(a), "v"(b), "v"(sc)); }
__device__ __forceinline__ void mfma_bf(f32x4& acc, bf16x8 a, bf16x8 b) { asm volatile("v_mfma_f32_16x16x32_bf16 %0, %1, %2, %0" : "+v"(acc) : "v"(a), "v"(b)); }
__device__ __forceinline__ void mfma_bfz(f32x4& acc, bf16x8 a, bf16x8 b) { asm volatile("v_mfma_f32_16x16x32_bf16 %0, %1, %2, 0" : "=&v"(acc) : "v"(a), "v"(b)); }
__device__ __forceinline__ void mfma_f8z(f32x4& acc, i32x8 a, i32x8 b, int sc) {
    asm volatile("v_mfma_scale_f32_16x16x128_f8f6f4 %0, %1, %2, 0, %3, %3 op_sel_hi:[0,0,0]" : "=&v"(acc) : "v"(a), "v"(b), "v"(sc)); }
__device__ __forceinline__ void tile_of(int L, int nM, int nN, int& pm, int& pn) {
    const int nwg = nM * nN; int wgid;
    { const int q = nwg / NXCD, r = nwg % NXCD, xcd = L % NXCD, off = L / NXCD; wgid = (xcd < r ? xcd * (q + 1) : r * (q + 1) + (xcd - r) * q) + off; }
    const int nig = WGM * nN, gid = wgid / nig, fm = gid * WGM, gsz = (nM - fm) < WGM ? (nM - fm) : WGM;
    pm = fm + ((wgid % nig) % gsz); pn = (wgid % nig) / gsz;
}
template <class P>
__device__ __forceinline__ void gemm_phase(LAS unsigned char* lds, const P& pr) {
    constexpr bool GATHER = P::GATHER;
    const int tid = threadIdx.x, wid = __builtin_amdgcn_readfirstlane(tid >> 6), lane = tid & 63, wr = wid >> 2, wc = wid & 3, fr = lane & 15, fq = lane >> 4;
    const int K = pr.K, nt = K / BK;
    unsigned voffB[2]; unsigned vAc[2][2], vAn[2][2]; int RA[2], CA[2];
    constexpr int PG8_TOK = STAGE_BYTES;
#pragma unroll
    for (int i = 0; i < 2; ++i) { int R, C; stage_rc(tid * 16 + i * 8192, R, C); const int Rb = P::PERM ? ((R & ~31) + perm32(R & 31)) : R;
        RA[i] = R; CA[i] = C; vAc[0][i] = (unsigned)(R * K + C) * 2u; vAc[1][i] = vAc[0][i]; vAn[0][i] = vAc[0][i]; vAn[1][i] = vAc[0][i]; voffB[i] = (unsigned)(Rb * K + C) * 2u; }
    const size_t kstep = (size_t)(BK * 2);
    const size_t hstep = (size_t)HALF * K * 2;
    const unsigned ldsw = (unsigned)wid * 1024u;
    const int aoff = lds_byte(wr * 64 + fr, fq * 8), boff = lds_byte(wc * 32 + fr, fq * 8);
#define PG8_SA(b, h) (((b) * 2 + (h)) * HTB)
#define PG8_SB(b, h) ((4 + (b) * 2 + (h)) * HTB)
#define PG8_STAGE(bufoff, gbase, voff) do { _Pragma("unroll") for (int _i = 0; _i < 2; ++_i) \
        __builtin_amdgcn_global_load_lds((const unsigned*)((const char*)(gbase) + (voff)[_i]), (LAS unsigned*)(lds + (bufoff) + ldsw + _i * 8192), 16, 0, 0); } while (0)
#define PG8_STAGE_A(bufoff, gbase, hh, V) PG8_STAGE(bufoff, (gbase) + (GATHER ? (size_t)0 : (size_t)(hh) * hstep), (V)[GATHER ? (hh) : 0])
#define PG8_LDA(dst, b, h) do { _Pragma("unroll") for (int m = 0; m < 4; ++m) _Pragma("unroll") for (int k = 0; k < 2; ++k) dst[m][k] = *(const LAS bf16x8*)(lds + PG8_SA(b, h) + aoff + m * 2048 + k * 1024); } while (0)
#define PG8_LDB(dst, b, h) do { _Pragma("unroll") for (int n = 0; n < 2; ++n) _Pragma("unroll") for (int k = 0; k < 2; ++k) dst[n][k] = *(const LAS bf16x8*)(lds + PG8_SB(b, h) + boff + n * 2048 + k * 1024); } while (0)
#define PG8_MMA(Z, ai, bj, At, Bt) do { __builtin_amdgcn_s_setprio(1); \
        if constexpr (P::FP8) { _Pragma("unroll") for (int m = 0; m < 4; ++m) _Pragma("unroll") for (int n = 0; n < 2; ++n) { \
            if constexpr (Z) pg8::mfma_f8z(acc[ai][bj][m][n], pg8::cat8(Bt[n][0], Bt[n][1]), pg8::cat8(At[m][0], At[m][1]), sc8); \
            else pg8::mfma_f8(acc[ai][bj][m][n], pg8::cat8(Bt[n][0], Bt[n][1]), pg8::cat8(At[m][0], At[m][1]), sc8); } } \
        else { _Pragma("unroll") for (int k = 0; k < 2; ++k) _Pragma("unroll") for (int m = 0; m < 4; ++m) _Pragma("unroll") for (int n = 0; n < 2; ++n) { \
            if ((Z) && k == 0) pg8::mfma_bfz(acc[ai][bj][m][n], Bt[n][k], At[m][k]); else pg8::mfma_bf(acc[ai][bj][m][n], Bt[n][k], At[m][k]); } } \
        __builtin_amdgcn_s_setprio(0); } while (0)
#define PG8_WAIT_V(n) asm volatile("s_waitcnt vmcnt(" #n ")" ::: "memory")
#define PG8_WAIT_L(n) asm volatile("s_waitcnt lgkmcnt(" #n ")" ::: "memory")
#define PG8_BAR __builtin_amdgcn_s_barrier()
#define PG8_SCHED __builtin_amdgcn_sched_barrier(0)
    Unit cur, nxt; int ui = 0;
    if (!pr.next(0, cur)) return;
    int sc8 = 0x7f7f7f7f; asm volatile("" : "+v"(sc8));
    (void)sc8;
    f32x4 acc[2][2][4][2];
    bf16x8 At[4][2], B0[2][2], B1[2][2];
    const char* cA = pr.a_base(cur); const char* cB = pr.b_base(cur);
    if constexpr (GATHER) {
#pragma unroll
        for (int h = 0; h < 2; ++h)
#pragma unroll
            for (int i = 0; i < 2; ++i) vAc[h][i] = pr.gather_off(cur, RA[i] + 128 * h) + (unsigned)CA[i] * 2u;
    }
    PG8_STAGE(PG8_SB(0, 0), cB, voffB); PG8_STAGE_A(PG8_SA(0, 0), cA, 0, vAc); PG8_STAGE(PG8_SB(0, 1), cB + hstep, voffB); PG8_STAGE_A(PG8_SA(0, 1), cA, 1, vAc);
    if (wr == 1) PG8_BAR;
    PG8_WAIT_V(4); PG8_BAR;
    PG8_STAGE(PG8_SB(1, 0), cB + kstep, voffB); PG8_STAGE_A(PG8_SA(1, 0), cA + kstep, 0, vAc); PG8_STAGE(PG8_SB(1, 1), cB + hstep + kstep, voffB);
    PG8_WAIT_V(6); PG8_BAR;
    for (;;) {
        pg8::Pre pre;
        if constexpr (P::HAS_PRE) pr.pre_load(cur, wr, wc, fr, fq, pre);
        const bool has_next = pr.next(ui + 1, nxt);
        const char* nA = has_next ? pr.a_base(nxt) : cA; const char* nB = has_next ? pr.b_base(nxt) : cB;
        if constexpr (GATHER) {
            if (has_next && wid < 4) __builtin_amdgcn_global_load_lds((const unsigned*)(pr.gather_ptr(nxt) + wid * 64 + lane), (LAS unsigned*)(lds + PG8_TOK + wid * 256), 4, 0, 0);
        }
#define PG8_KBODY(Z) { \
            const bool last = (t == nt - 2); \
            const char* a1 = cA + (size_t)(t + 1) * kstep; \
            const char* a2 = last ? nA : cA + (size_t)(t + 2) * kstep; const char* b2 = last ? nB : cB + (size_t)(t + 2) * kstep; \
            const char* a3 = a2 + kstep; const char* b3 = b2 + kstep; \
            unsigned vA2[2][2]; \
            if constexpr (GATHER) { \
                if (last && has_next) { \
_Pragma("unroll") \
                    for (int h = 0; h < 2; ++h) \
_Pragma("unroll") \
                        for (int i = 0; i < 2; ++i) vAn[h][i] = pr.gather_fin(*(volatile LAS int*)(lds + PG8_TOK + (RA[i] + 128 * h) * 4)) + (unsigned)CA[i] * 2u; \
                } \
_Pragma("unroll") \
                for (int h = 0; h < 2; ++h) \
_Pragma("unroll") \
                    for (int i = 0; i < 2; ++i) vA2[h][i] = (last && has_next) ? vAn[h][i] : vAc[h][i]; \
            } else { \
_Pragma("unroll") \
                for (int h = 0; h < 2; ++h) \
_Pragma("unroll") \
                    for (int i = 0; i < 2; ++i) vA2[h][i] = vAc[0][i]; \
            } \
            PG8_LDB(B0, 0, 0); PG8_SCHED; PG8_LDA(At, 0, 0); PG8_STAGE_A(PG8_SA(1, 1), a1, 1, vAc); \
            PG8_WAIT_L(8); PG8_BAR; PG8_WAIT_L(0); PG8_MMA(Z, 0, 0, At, B0); PG8_BAR; PG8_SCHED; \
            PG8_LDB(B1, 0, 1); PG8_STAGE(PG8_SB(0, 0), b2, voffB); \
            PG8_BAR; PG8_WAIT_L(0); PG8_MMA(Z, 0, 1, At, B1); PG8_BAR; \
            PG8_LDA(At, 0, 1); PG8_STAGE_A(PG8_SA(0, 0), a2, 0, vA2); \
            PG8_BAR; PG8_WAIT_L(0); PG8_MMA(Z, 1, 0, At, B0); PG8_BAR; PG8_SCHED; \
            PG8_STAGE(PG8_SB(0, 1), b2 + hstep, voffB); \
            PG8_WAIT_V(6); PG8_BAR; PG8_MMA(Z, 1, 1, At, B1); PG8_BAR; \
            PG8_LDB(B0, 1, 0); PG8_SCHED; PG8_LDA(At, 1, 0); PG8_STAGE_A(PG8_SA(0, 1), a2, 1, vA2); \
            PG8_WAIT_L(8); PG8_BAR; PG8_WAIT_L(0); PG8_MMA(false, 0, 0, At, B0); PG8_BAR; PG8_SCHED; \
            PG8_LDB(B1, 1, 1); PG8_STAGE(PG8_SB(1, 0), b3, voffB); \
            PG8_BAR; PG8_WAIT_L(0); PG8_MMA(false, 0, 1, At, B1); PG8_BAR; \
            PG8_LDA(At, 1, 1); PG8_STAGE_A(PG8_SA(1, 0), a3, 0, vA2); \
            PG8_BAR; PG8_WAIT_L(0); PG8_MMA(false, 1, 0, At, B0); PG8_BAR; PG8_SCHED; \
            PG8_STAGE(PG8_SB(1, 1), b3 + hstep, voffB); \
            PG8_WAIT_V(6); PG8_BAR; PG8_MMA(false, 1, 1, At, B1); PG8_BAR; \
        }
        { constexpr int t = 0; PG8_KBODY(true) }
        for (int t = 2; t < nt; t += 2) PG8_KBODY(false)
#undef PG8_KBODY
        {
            asm volatile("s_nop 15\n\ts_nop 15" ::: "memory");
#pragma unroll
            for (int a = 0; a < 2; ++a)
#pragma unroll
                for (int b = 0; b < 2; ++b)
#pragma unroll
                    for (int m = 0; m < 4; ++m)
#pragma unroll
                        for (int n = 0; n < 2; ++n) asm volatile("" : "+v"(acc[a][b][m][n]));
        }
        pr.epi(acc, cur, wr, wc, fr, fq, pre);
#if EPI_REPS > 1
        if constexpr (P::EPI2) { for (int er = 1; er < EPI_REPS; ++er) { asm volatile("" ::: "memory"); pr.epi(acc, cur, wr, wc, fr, fq, pre); } }
#endif
        if (!has_next) break;
        cur = nxt; cA = nA; cB = nB; ++ui;
        if constexpr (GATHER) {
#pragma unroll
            for (int h = 0; h < 2; ++h)
#pragma unroll
                for (int i = 0; i < 2; ++i) vAc[h][i] = vAn[h][i];
        }
    }
    PG8_WAIT_V(0);
    if (wr == 0) PG8_BAR;
    PG8_BAR;
#undef PG8_SA
#undef PG8_SB
#undef PG8_STAGE
#undef PG8_STAGE_A
#undef PG8_LDA
#undef PG8_LDB
#undef PG8_MMA
#undef PG8_WAIT_V
#undef PG8_WAIT_L
#undef PG8_BAR
#undef PG8_SCHED
}
}

struct Frame {
    LAS unsigned char* lds;
    int tid, lane, wave, vcu, G;
    const float* in[28]; float* out; unsigned char* ws;
};
enum { I_X = 0, I_GMIX, I_WIN, I_CAW, I_CAB, I_LWR, I_LBR, I_LWI, I_LBI, I_LAM, I_WAOUT, I_CBW, I_CBB, I_FW1, I_FB1, I_FW2, I_FB2, I_FW3, I_FFREQ, I_FBIAS, I_WBOUT, I_WO, I_GFFN, I_WROUTER, I_WGATE, I_WUP, I_WDOWN, I_GFINAL };

constexpr float W8_SCALE = 64.0f, W8_INV = 1.0f / 64.0f;
__device__ __forceinline__ float fp8_clamp(float x) { return __builtin_amdgcn_fmed3f(x, -448.0f, 448.0f); }
__device__ __forceinline__ unsigned pk4_fp8(float a, float b, float c, float d) { int w = 0; w = __builtin_amdgcn_cvt_pk_fp8_f32(a, b, w, false); w = __builtin_amdgcn_cvt_pk_fp8_f32(c, d, w, true); return (unsigned)w; }
struct F8Item { const float* W; unsigned char* WT; int K, N, mode, off, item; };
__device__ __forceinline__ void f8_issue(const F8Item& q, int lane, f32x4 (&v)[16]) {
    const int nblk = q.N / 64, kb = q.item / nblk, nb = q.item % nblk, k0 = 64 * kb, n0 = 64 * nb;
    const int r4 = lane >> 4, c4 = (lane & 15) * 4;
#pragma unroll
    for (int i = 0; i < 16; ++i) v[i] = *(const f32x4*)(q.W + (size_t)(k0 + 16 * r4 + i) * q.N + n0 + c4);
}
__device__ __forceinline__ void f8_finish(const F8Item& q, int lane, const f32x4 (&v)[16]) {
    const int nblk = q.N / 64, kb = q.item / nblk, nb = q.item % nblk, k0 = 64 * kb, n0 = 64 * nb;
    const int r4 = lane >> 4, c4 = (lane & 15) * 4;
#pragma unroll
    for (int j = 0; j < 4; ++j) { u32x4 o;
#pragma unroll
        for (int qd = 0; qd < 4; ++qd) o[qd] = pk4_fp8(v[4 * qd][j] * W8_SCALE, v[4 * qd + 1][j] * W8_SCALE, v[4 * qd + 2][j] * W8_SCALE, v[4 * qd + 3][j] * W8_SCALE);
        const int nn = n0 + c4 + j; const int row = (q.mode ? (256 * (nn >> 7) + (nn & 127)) : nn) + q.off;
        *(u32x4*)(q.WT + (size_t)row * q.K + k0 + 16 * r4) = o; }
}
__device__ __forceinline__ void transpose_item(const float* W, int K, int N, bf16_t* WT, const float* scale, int mode, int off, LAS unsigned char* scr, int item, int lane) {
    const int nblk = N / 64, kb = item / nblk, nb = item % nblk, k0 = 64 * kb, n0 = 64 * nb;
    const int r4 = lane >> 4, c4 = (lane & 15) * 4;
    f32x4 v[16];
#pragma unroll
    for (int i = 0; i < 16; ++i) v[i] = *(const f32x4*)(W + (size_t)(k0 + 4 * i + r4) * N + n0 + c4);
    float sc[16];
    if (scale) {
#pragma unroll
        for (int i = 0; i < 16; ++i) sc[i] = scale[k0 + 4 * i + r4]; }
#pragma unroll
    for (int i = 0; i < 16; ++i) { const int kk = 4 * i + r4; f32x4 x = v[i]; if (scale) x = x * sc[i];
        LAS unsigned* d = (LAS unsigned*)(scr + kk * 132 + c4 * 2); d[0] = pk2(x.x, x.y); d[1] = pk2(x.z, x.w); }
    LDS_WAIT();
    const int c = lane & 7;
#pragma unroll
    for (int j = 0; j < 8; ++j) { const int n = 8 * j + (lane >> 3); const LAS bf16_t* sp = (const LAS bf16_t*)(scr + (8 * c) * 132 + n * 2);
        u32x4 o; o.x = (unsigned)sp[0] | ((unsigned)sp[66] << 16); o.y = (unsigned)sp[132] | ((unsigned)sp[198] << 16); o.z = (unsigned)sp[264] | ((unsigned)sp[330] << 16); o.w = (unsigned)sp[396] | ((unsigned)sp[462] << 16);
        const int nn = n0 + n; const int row = (mode ? (256 * (nn >> 7) + (nn & 127)) : nn) + off;
        *(u32x4*)(WT + (size_t)row * K + k0 + 8 * c) = o; }
    LDS_WAIT();
}
__device__ __forceinline__ void row_load(const float* base, int m, int lane, f32x4 (&v)[4]) {
    const f32x4* xr = (const f32x4*)(base + (size_t)m * DM) + lane;
#pragma unroll
    for (int j = 0; j < 4; ++j) v[j] = xr[64 * j];
}
__device__ __forceinline__ void row_load_bf(const bf16_t* base, int m, int lane, u32x2 (&v)[4]) {
    const u32x2* xr = (const u32x2*)(base + (size_t)m * DM) + lane;
#pragma unroll
    for (int j = 0; j < 4; ++j) v[j] = xr[64 * j];
}
__device__ __forceinline__ f32x4 bf4(u32x2 w) { return (f32x4){bflo(w.x), bfhi(w.x), bflo(w.y), bfhi(w.y)}; }
__device__ __forceinline__ void p0_row(Frame& F, int m, const f32x4 (&v)[4]) {
    float s = 0.f;
#pragma unroll
    for (int j = 0; j < 4; ++j) s += (v[j].x * v[j].x + v[j].y * v[j].y) + (v[j].z * v[j].z + v[j].w * v[j].w);
    s = wave_sum(s);
    const float rstd = 1.0f / sqrtf(s * (1.0f / DM) + EPS);
    unsigned long long* o8 = (unsigned long long*)((bf16_t*)(F.ws + WS_XB) + (size_t)m * DM) + F.lane;
#pragma unroll
    for (int j = 0; j < 4; ++j) o8[64 * j] = (unsigned long long)pk2(v[j].x, v[j].y) | ((unsigned long long)pk2(v[j].z, v[j].w) << 32);
    if (F.lane == 0) ((float*)(F.ws + WS_RSTD1))[m] = rstd;
}
__device__ __forceinline__ void p0_filter_item(Frame& F, int tb) {
    LAS float* zb = (LAS float*)(F.lds); LAS float* h1 = (LAS float*)(F.lds + 4096); LAS float* h2T = (LAS float*)(F.lds + 8192);
    const float* w1 = F.in[I_FW1]; const float* b1 = F.in[I_FB1]; const float* w2 = F.in[I_FW2]; const float* b2 = F.in[I_FB2];
    const float* w3 = F.in[I_FW3]; const float* freq = F.in[I_FFREQ]; const float* fbias = F.in[I_FBIAS];
    const int t0 = tb * 16;
    for (int idx = F.tid; idx < 16 * 33; idx += NTHREADS) { const int tt = idx / 33, i = idx % 33, t = t0 + tt; float val;
        if (i == 0) val = (float)t * (1.0f / 4095.0f);
        else { const int k = (i - 1) & 15; const float fk = 1e-4f + (float)k * ((15.0f - 1e-4f) / 15.0f); const float w = (6.283185307179586f / 4096.0f) * (float)t; const float ang = w * fk;
            val = (i <= 16) ? cosf(ang) : -sinf(ang); }
        zb[tt * 36 + i] = val; }
    __syncthreads();
    for (int idx = F.tid; idx < 1024; idx += NTHREADS) { const int tt = idx >> 6, k = idx & 63; float s = b1[k];
        for (int i = 0; i < 33; ++i) s += zb[tt * 36 + i] * w1[i * 64 + k];
        h1[tt * 64 + k] = sinf(freq[k] * s); }
    __syncthreads();
    for (int idx = F.tid; idx < 1024; idx += NTHREADS) { const int tt = idx >> 6, k = idx & 63; float s = b2[k];
        for (int j = 0; j < 64; ++j) s += h1[tt * 64 + j] * w2[j * 64 + k];
        h2T[k * 16 + tt] = sinf(freq[64 + k] * s); }
    __syncthreads();
    const float min_decay = -3.0701134573f, max_decay = -15.3505672865f;
    bf16_t* FG = (bf16_t*)(F.ws + WS_FG);
    const int g = F.lane >> 4, j16 = F.lane & 15;
    float afr[16];
#pragma unroll
    for (int st = 0; st < 16; ++st) afr[st] = h2T[(4 * st + g) * 16 + j16];
#pragma unroll 1
    for (int blk = 0; blk < 8; ++blk) {
        const int col0 = 512 * F.wave + 64 * blk + 4 * j16;
        f32x4 bw[16];
#pragma unroll
        for (int st = 0; st < 16; ++st) bw[st] = *(const f32x4*)(w3 + (size_t)(4 * st + g) * 4096 + col0);
        __builtin_amdgcn_sched_barrier(0);
        f32x4 acc[4];
#pragma unroll
        for (int q = 0; q < 4; ++q) acc[q] = (f32x4){0.f, 0.f, 0.f, 0.f};
#pragma unroll
        for (int st = 0; st < 16; ++st)
#pragma unroll
            for (int q = 0; q < 4; ++q) acc[q] = __builtin_amdgcn_mfma_f32_16x16x4f32(afr[st], bw[st][q], acc[q], 0, 0, 0);
#pragma unroll
        for (int q = 0; q < 4; ++q) { const int col = col0 + q, n = col >> 11, dir = (col >> 10) & 1, c = col & 1023;
            const float dl = fabsf(min_decay + (float)c * ((max_decay - min_decay) / 1023.0f)) * -1.44269504089f;
            float o[4];
#pragma unroll
            for (int r = 0; r < 4; ++r) { const int t = t0 + 4 * g + r; o[r] = acc[q][r] * __builtin_amdgcn_exp2f((float)t * (1.0f / 4095.0f) * dl); }
            if (dir == 0 && t0 == 0 && g == 0) o[0] += fbias[n * 1024 + c];
            u32x2 w; w.x = cvt_pk_bf16(o[0], o[1]); w.y = cvt_pk_bf16(o[2], o[3]);
            *(u32x2*)(FG + ((size_t)((n * 2 + dir) * 1024 + c)) * 4096 + t0 + 4 * g) = w; }
    }
    __syncthreads();
}
__device__ __forceinline__ void p0_streaming(Frame& F) {
    LAS unsigned char* scr = F.lds + F.wave * 16384;
    const int gw = F.vcu * NWAVES + F.wave, NGW = F.G * NWAVES;
    constexpr int I_IN = (DM / 64) * (INCOLS / 64), I_SQ = (DM / 64) * (DM / 64);
    for (int it = gw; it < (I_IN + 3 * I_SQ) * REPS(0); it += NGW) {
        int r = REPS(0) > 1 ? it % (I_IN + 3 * I_SQ) : it;
        if (r < I_IN) { transpose_item(F.in[I_WIN], DM, INCOLS, (bf16_t*)(F.ws + WS_WINT), F.in[I_GMIX], 0, 0, scr, r, F.lane); continue; } r -= I_IN;
        if (r < I_SQ) { transpose_item(F.in[I_WAOUT], DM, DM, (bf16_t*)(F.ws + WS_WA), nullptr, 0, 0, scr, r, F.lane); continue; } r -= I_SQ;
        if (r < I_SQ) { transpose_item(F.in[I_WBOUT], DM, DM, (bf16_t*)(F.ws + WS_WB), nullptr, 0, 0, scr, r, F.lane); continue; } r -= I_SQ;
        transpose_item(F.in[I_WO], DM, DM, (bf16_t*)(F.ws + WS_WO), nullptr, 0, 0, scr, r, F.lane);
    }
    { f32x4 cur[4], nxt[4];
      if (gw < NT) row_load(F.in[I_X], gw, F.lane, cur);
      for (int m0 = gw; m0 < NT * REPS(0); m0 += NGW) { const int m = REPS(0) > 1 ? m0 % NT : m0, mn = REPS(0) > 1 ? (m0 + NGW) % NT : m0 + NGW;
#pragma unroll
          for (int j = 0; j < 4; ++j) nxt[j] = cur[j];
          if (m0 + NGW < NT * REPS(0)) row_load(F.in[I_X], mn, F.lane, nxt);
          p0_row(F, m, cur);
#pragma unroll
          for (int j = 0; j < 4; ++j) cur[j] = nxt[j]; } }
}
__device__ __forceinline__ void phase0(Frame& F) {
    if ((F.vcu & 1) == 0) { for (int tb = F.vcu; tb < 256 * REPS(15) * REPS(0); tb += F.G) p0_filter_item(F, tb & 255); __syncthreads(); p0_streaming(F); }
    else { p0_streaming(F); __syncthreads(); for (int tb = F.vcu; tb < 256 * REPS(15) * REPS(0); tb += F.G) p0_filter_item(F, tb & 255); }
}

using pg8::Unit;
typedef f32x4 Acc[2][2][4][2];
struct ProbG1 {
    static constexpr bool PERM = true, GATHER = false, FP8 = false, EPI2 = true, HAS_PRE = true; static constexpr int EPI_ST = 16;
    int K, G, c; const char* xb; const char* wint; bf16_t* ax; bf16_t* gg; bf16_t* gates; bf16_t* hyt; const float* rstd;
    __device__ __forceinline__ bool next(int i, Unit& u) const {
        int L = i * G + c; if (L >= (2048 + 1536) * REPS(1)) return false; if (REPS(1) > 1) L %= 2048 + 1536;
        if (L < 2048) { u.g = 0; pg8::tile_of(L, 128, 16, u.pm, u.pn); } else { u.g = 1; pg8::tile_of(L - 2048, 12, 128, u.pm, u.pn); }
        return true; }
    __device__ __forceinline__ const char* a_base(const Unit& u) const { return u.g == 0 ? xb + (size_t)u.pm * 256 * 2048 : wint + (size_t)(2048 + 256 * u.pm) * 2048; }
    __device__ __forceinline__ const char* b_base(const Unit& u) const { return u.g == 0 ? wint + (size_t)(u.pn < 8 ? 256 * u.pn : 256 * u.pn + 3072) * 2048 : xb + (size_t)u.pn * 256 * 2048; }
    __device__ __forceinline__ unsigned gather_off(const Unit&, int) const { return 0u; }
    __device__ __forceinline__ const int* gather_ptr(const Unit&) const { return nullptr; }
    __device__ __forceinline__ unsigned gather_fin(int) const { return 0u; }
    __device__ __forceinline__ void pre_load(const Unit& u, int wr, int wc, int fr, int fq, pg8::Pre& pre) const {
        if (u.g == 0) { const float* p = rstd + u.pm * 256 + wr * 64 + fr;
            pre.a = (f32x4){p[0], p[16], p[32], p[48]}; pre.b = (f32x4){p[128], p[144], p[160], p[176]}; pre.c = pre.a; pre.d = pre.b;
        } else { const float* p = rstd + u.pn * 256 + wc * 32 + 8 * fq;
            pre.a = *(const f32x4*)p; pre.b = *(const f32x4*)(p + 4); pre.c = *(const f32x4*)(p + 128); pre.d = *(const f32x4*)(p + 132); }
    }
    __device__ __forceinline__ void epi(const Acc& acc, const Unit& u, int wr, int wc, int fr, int fq, const pg8::Pre& pre) const {
        if (u.g == 0) {
            const int row0 = u.pm * 256 + wr * 64 + fr, cl = wc * 32 + 8 * fq;
#pragma unroll
            for (int ai = 0; ai < 2; ++ai)
#pragma unroll
                for (int m = 0; m < 4; ++m) { const int row = row0 + ai * 128 + m * 16; const float rs = ai == 0 ? pre.a[m] : pre.b[m];
#pragma unroll
                    for (int bj = 0; bj < 2; ++bj) { float o[8]; bf16_t* dst;
                        if (u.pn < 4) { dst = ax + (size_t)row * DM + u.pn * 256 + bj * 128 + cl;
#pragma unroll
                            for (int j = 0; j < 8; ++j) o[j] = acc[ai][bj][m][j >> 2][j & 3] * rs; }
                        else if (u.pn < 8) { dst = gg + (size_t)row * DM + (u.pn - 4) * 256 + bj * 128 + cl;
                            constexpr float k0 = -1.5957691216f * 1.44269504089f, k1 = k0 * 0.044715f;
#pragma unroll
                            for (int j = 0; j < 8; ++j) { const float x = acc[ai][bj][m][j >> 2][j & 3] * rs; const float w = __builtin_fmaf(x * x, k1, k0);
                                o[j] = x * fast_rcp(1.0f + __builtin_amdgcn_exp2f(x * w)); } }
                        else { dst = gates + (size_t)row * 2048 + (u.pn - 8) * 256 + bj * 128 + cl; const float rn = rs * -1.44269504089f;
#pragma unroll
                            for (int j = 0; j < 8; ++j) o[j] = fast_rcp(1.0f + __builtin_amdgcn_exp2f(acc[ai][bj][m][j >> 2][j & 3] * rn)); }
                        u32x4 w; w.x = cvt_pk_bf16(o[0], o[1]); w.y = cvt_pk_bf16(o[2], o[3]); w.z = cvt_pk_bf16(o[4], o[5]); w.w = cvt_pk_bf16(o[6], o[7]);
                        *(u32x4*)dst = w; } }
        } else {
            const int ch0 = u.pm * 256 + wr * 64 + fr, tl = u.pn * 256 + wc * 32 + 8 * fq;
            const f32x4 rs[2][2] = {{pre.a, pre.b}, {pre.c, pre.d}};
#pragma unroll
            for (int ai = 0; ai < 2; ++ai)
#pragma unroll
                for (int m = 0; m < 4; ++m) { const int ch = ch0 + ai * 128 + m * 16; const int part = ch >> 10, cc = ch & 1023;
#pragma unroll
                    for (int bj = 0; bj < 2; ++bj) { const int tok = tl + bj * 128; const int b = tok >> 12, s = tok & 4095;
                        const f32x4 v0 = acc[ai][bj][m][0] * rs[bj][0], v1 = acc[ai][bj][m][1] * rs[bj][1];
                        u32x4 w; w.x = cvt_pk_bf16(v0[0], v0[1]); w.y = cvt_pk_bf16(v0[2], v0[3]); w.z = cvt_pk_bf16(v1[0], v1[1]); w.w = cvt_pk_bf16(v1[2], v1[3]);
                        *(u32x4*)(hyt + ((size_t)((part * NB + b) * DM + cc)) * SEQ + s) = w; } }
        }
    }
};
struct ProbG4 {
    static constexpr bool PERM = true, GATHER = false, FP8 = false, EPI2 = false, HAS_PRE = false; static constexpr int EPI_ST = 16;
    int K, G, c; const char* ua; const char* ub; const char* wa; const char* wb; const bf16_t* gates; bf16_t* merged; f32x4* tmp;
    __device__ __forceinline__ bool next(int i, Unit& u) const { int L = (i >> 1) * G + c; if (L >= 512 * REPS(4)) return false; if (REPS(4) > 1) L %= 512; u.g = i & 1; pg8::tile_of(L, 128, 4, u.pm, u.pn); return true; }
    __device__ __forceinline__ const char* a_base(const Unit& u) const { return (u.g == 0 ? ua : ub) + (size_t)u.pm * 256 * 2048; }
    __device__ __forceinline__ const char* b_base(const Unit& u) const { return (u.g == 0 ? wa : wb) + (size_t)u.pn * 256 * 2048; }
    __device__ __forceinline__ unsigned gather_off(const Unit&, int) const { return 0u; }
    __device__ __forceinline__ const int* gather_ptr(const Unit&) const { return nullptr; }
    __device__ __forceinline__ unsigned gather_fin(int) const { return 0u; }
    __device__ __forceinline__ void epi(const Acc& acc, const Unit& u, int wr, int wc, int fr, int fq, const pg8::Pre& pre) const {
        const int row0 = u.pm * 256 + wr * 64 + fr, col0 = u.pn * 256 + wc * 32 + 8 * fq;
        const int goff = u.g == 0 ? 0 : 1024;
#pragma unroll
        for (int ai = 0; ai < 2; ++ai) {
            u32x4 gv[4][2], pv[4][2];
#pragma unroll
            for (int m = 0; m < 4; ++m) { const int row = row0 + ai * 128 + m * 16;
#pragma unroll
                for (int bj = 0; bj < 2; ++bj) { const int col = col0 + bj * 128;
                    gv[m][bj] = *(const u32x4*)(gates + (size_t)row * 2048 + goff + col);
                    pv[m][bj] = (u32x4){0u, 0u, 0u, 0u};
                    if (u.g != 0) pv[m][bj] = *(const u32x4*)(merged + (size_t)row * DM + col); } }
#pragma unroll
            for (int m = 0; m < 4; ++m) { const int row = row0 + ai * 128 + m * 16;
#pragma unroll
                for (int bj = 0; bj < 2; ++bj) { const int col = col0 + bj * 128; const u32x4 g4 = gv[m][bj], p4 = pv[m][bj];
                    const f32x4 a0 = acc[ai][bj][m][0], a1 = acc[ai][bj][m][1];
                    u32x4 w;
                    w.x = cvt_pk_bf16(bflo(g4.x) * a0[0] + bflo(p4.x), bfhi(g4.x) * a0[1] + bfhi(p4.x));
                    w.y = cvt_pk_bf16(bflo(g4.y) * a0[2] + bflo(p4.y), bfhi(g4.y) * a0[3] + bfhi(p4.y));
                    w.z = cvt_pk_bf16(bflo(g4.z) * a1[0] + bflo(p4.z), bfhi(g4.z) * a1[1] + bfhi(p4.z));
                    w.w = cvt_pk_bf16(bflo(g4.w) * a1[2] + bflo(p4.w), bfhi(g4.w) * a1[3] + bfhi(p4.w));
                    *(u32x4*)(merged + (size_t)row * DM + col) = w; } }
            asm volatile("" ::: "memory");
        }
    }
};
struct ProbG5 {
    static constexpr bool PERM = true, GATHER = false, FP8 = false, EPI2 = true, HAS_PRE = false; static constexpr int EPI_ST = 16;
    int K, G, c; const char* a; const char* b; const float* x; bf16_t* xmid;
    __device__ __forceinline__ bool next(int i, Unit& u) const { int L = i * G + c; if (L >= 512 * REPS(5)) return false; if (REPS(5) > 1) L %= 512; u.g = 0; pg8::tile_of(L, 128, 4, u.pm, u.pn); return true; }
    __device__ __forceinline__ const char* a_base(const Unit& u) const { return a + (size_t)u.pm * 256 * 2048; }
    __device__ __forceinline__ const char* b_base(const Unit& u) const { return b + (size_t)u.pn * 256 * 2048; }
    __device__ __forceinline__ unsigned gather_off(const Unit&, int) const { return 0u; }
    __device__ __forceinline__ const int* gather_ptr(const Unit&) const { return nullptr; }
    __device__ __forceinline__ unsigned gather_fin(int) const { return 0u; }
    __device__ __forceinline__ void epi(const Acc& acc, const Unit& u, int wr, int wc, int fr, int fq, const pg8::Pre&) const {
        const int row0 = u.pm * 256 + wr * 64 + fr, col0 = u.pn * 256 + wc * 32 + 8 * fq;
#pragma unroll
        for (int ai = 0; ai < 2; ++ai) {
            f32x4 xv[4][2][2];
#pragma unroll
            for (int m = 0; m < 4; ++m) { const size_t off = (size_t)(row0 + ai * 128 + m * 16) * DM + col0;
#pragma unroll
                for (int bj = 0; bj < 2; ++bj)
#pragma unroll
                    for (int n = 0; n < 2; ++n) xv[m][bj][n] = *(const f32x4*)(x + off + bj * 128 + n * 4); }
#pragma unroll
            for (int m = 0; m < 4; ++m) { const size_t off = (size_t)(row0 + ai * 128 + m * 16) * DM + col0;
#pragma unroll
                for (int bj = 0; bj < 2; ++bj) { const f32x4 v0 = xv[m][bj][0] + acc[ai][bj][m][0], v1 = xv[m][bj][1] + acc[ai][bj][m][1];
                    u32x4 w; w.x = cvt_pk_bf16(v0[0], v0[1]); w.y = cvt_pk_bf16(v0[2], v0[3]); w.z = cvt_pk_bf16(v1[0], v1[1]); w.w = cvt_pk_bf16(v1[2], v1[3]);
                    *(u32x4*)(xmid + off + bj * 128) = w; } }
            asm volatile("" ::: "memory");
        }
    }
};
struct ProbG8 {
    static constexpr bool PERM = true, GATHER = true, FP8 = true, EPI2 = true, HAS_PRE = false; static constexpr int EPI_ST = 8;
    int K, G, c; const char* h2; const char* wgu; const int* tok; unsigned char* act;
    __device__ __forceinline__ bool next(int i, Unit& u) const { int L = i * G + c; if (L >= 4096 * REPS(8)) return false; if (REPS(8) > 1) L %= 4096; u.g = L >> 8; pg8::tile_of(L & 255, 16, 16, u.pm, u.pn); return true; }
    __device__ __forceinline__ const char* a_base(const Unit&) const { return h2; }
    __device__ __forceinline__ const char* b_base(const Unit& u) const { return wgu + (size_t)(u.g * 4096 + 256 * u.pn) * 1024; }
    __device__ __forceinline__ unsigned gather_off(const Unit& u, int row) const { return (unsigned)tok[u.g * 4096 + 256 * u.pm + row] * 1024u; }
    __device__ __forceinline__ const int* gather_ptr(const Unit& u) const { return tok + u.g * 4096 + 256 * u.pm; }
    __device__ __forceinline__ unsigned gather_fin(int raw) const { return (unsigned)raw * 1024u; }
    __device__ __forceinline__ void epi(const Acc& acc, const Unit& u, int wr, int wc, int fr, int fq, const pg8::Pre& pre) const {
        const int row0 = u.pm * 256 + wr * 64 + fr, col0 = u.pn * 128 + wc * 32 + 8 * fq;
#pragma unroll
        for (int ai = 0; ai < 2; ++ai)
#pragma unroll
            for (int m = 0; m < 4; ++m) { const int row = row0 + ai * 128 + m * 16; float o[8];
#pragma unroll
                for (int n = 0; n < 2; ++n)
#pragma unroll
                    for (int j = 0; j < 4; ++j) { const float ag = acc[ai][0][m][n][j], au = acc[ai][1][m][n][j];
                        const float e = __builtin_amdgcn_exp2f(ag * (-1.44269504089f * W8_INV));
                        o[4 * n + j] = fp8_clamp((ag * au) * fast_rcp(__builtin_fmaf(e, 4096.0f, 4096.0f))); }
                u32x2 w; w.x = pk4_fp8(o[0], o[1], o[2], o[3]); w.y = pk4_fp8(o[4], o[5], o[6], o[7]);
                *(u32x2*)(act + ((size_t)(u.g * 4096 + row)) * DFF + col0) = w; }
    }
};
struct ProbG9 {
    static constexpr bool PERM = true, GATHER = false, FP8 = true, EPI2 = true, HAS_PRE = true; static constexpr int EPI_ST = 16;
    int K, G, c; const char* act; const char* wd; const float* val; bf16_t* ye;
    __device__ __forceinline__ bool next(int i, Unit& u) const { int L = i * G + c; if (L >= 1024 * REPS(9)) return false; if (REPS(9) > 1) L %= 1024; u.g = L >> 6; pg8::tile_of(L & 63, 16, 4, u.pm, u.pn); return true; }
    __device__ __forceinline__ const char* a_base(const Unit& u) const { return act + (size_t)(u.g * 4096 + 256 * u.pm) * 2048; }
    __device__ __forceinline__ const char* b_base(const Unit& u) const { return wd + (size_t)(u.g * 1024 + 256 * u.pn) * 2048; }
    __device__ __forceinline__ unsigned gather_off(const Unit&, int) const { return 0u; }
    __device__ __forceinline__ const int* gather_ptr(const Unit&) const { return nullptr; }
    __device__ __forceinline__ unsigned gather_fin(int) const { return 0u; }
    __device__ __forceinline__ void pre_load(const Unit& u, int wr, int, int fr, int, pg8::Pre& pre) const { const int row0 = u.pm * 256 + wr * 64 + fr;
        const float* p = val + u.g * 4096 + row0;
        pre.a = (f32x4){p[0], p[16], p[32], p[48]}; pre.b = (f32x4){p[128], p[144], p[160], p[176]}; pre.c = pre.a; pre.d = pre.b; }
    __device__ __forceinline__ void epi(const Acc& acc, const Unit& u, int wr, int wc, int fr, int fq, const pg8::Pre& pre) const {
        const int row0 = u.pm * 256 + wr * 64 + fr, col0 = u.pn * 256 + wc * 32 + 8 * fq;
#pragma unroll
        for (int ai = 0; ai < 2; ++ai)
#pragma unroll
            for (int m = 0; m < 4; ++m) { const int row = row0 + ai * 128 + m * 16; const float vs = (ai == 0 ? pre.a[m] : pre.b[m]) * W8_INV;
#pragma unroll
                for (int bj = 0; bj < 2; ++bj) { const f32x4 v0 = acc[ai][bj][m][0] * vs, v1 = acc[ai][bj][m][1] * vs;
                    u32x4 w; w.x = cvt_pk_bf16(v0[0], v0[1]); w.y = cvt_pk_bf16(v0[2], v0[3]); w.z = cvt_pk_bf16(v1[0], v1[1]); w.w = cvt_pk_bf16(v1[2], v1[3]);
                    *(u32x4*)(ye + ((size_t)(u.g * 4096 + row)) * DM + col0 + bj * 128) = w; } }
    }
};

constexpr int MA_WT_BYTES = 4 * 64 * 144, MA_SCR = 15744, MA_RAW = 11264, MA_XAT = 4608, MA_CB = 9216;
static_assert(MA_WT_BYTES + 8 * MA_SCR <= LDS_MISC, "mixer-A LDS");
__device__ __forceinline__ void mixer_a_load_w(Frame& F, int head) {
    LAS unsigned char* WT = F.lds;
    for (int idx = F.tid; idx < 4 * 4096; idx += NTHREADS) { const int mat = idx >> 12, i = (idx >> 6) & 63, j = idx & 63;
        const float* src = (mat & 1) ? F.in[I_LWI] : F.in[I_LWR]; const int dir = mat >> 1;
        const float v = src[(size_t)(dir * 16 + head) * 4096 + i * 64 + j];
        *(LAS bf16_t*)(WT + (mat * 64 + j) * 144 + i * 2) = (bf16_t)f2bf(v * -1.44269504089f); }
}
template <int PASS>
__device__ __forceinline__ void mixer_a_unit(Frame& F, int b, int head, int g) {
    LAS unsigned char* WT = F.lds; LAS unsigned char* scr = F.lds + MA_WT_BYTES + F.wave * MA_SCR;
    LAS unsigned char* raw = scr + MA_RAW; LAS unsigned char* xat = scr + MA_XAT; LAS float* cbuf = (LAS float*)(scr + MA_CB);
    const int lane = F.lane, col = lane & 31, h = lane >> 5;
    const bf16_t* AX = (const bf16_t*)(F.ws + WS_AX); const bf16_t* GG = (const bf16_t*)(F.ws + WS_GG); bf16_t* UA = (bf16_t*)(F.ws + WS_XB);
    f32x4* AGG = (f32x4*)(F.ws + WS_AGG); f32x4* GAGG = (f32x4*)(F.ws + WS_GAGG);
    float cw[2][4], cbias[2], br0[2], br1[2], bi0[2], bi1[2], sp0[2], sp1[2];
#pragma unroll
    for (int nt = 0; nt < 2; ++nt) { const int ch = head * 64 + 32 * nt + col;
#pragma unroll
        for (int k = 0; k < 4; ++k) cw[nt][k] = F.in[I_CAW][k * DM + ch];
        cbias[nt] = F.in[I_CAB][ch];
        br0[nt] = -1.44269504089f * F.in[I_LBR][ch]; br1[nt] = -1.44269504089f * F.in[I_LBR][DM + ch]; bi0[nt] = -1.44269504089f * F.in[I_LBI][ch]; bi1[nt] = -1.44269504089f * F.in[I_LBI][DM + ch];
        sp0[nt] = -8.0f * 1.44269504089f * log1pf(expf(-F.in[I_LAM][ch])); sp1[nt] = -8.0f * 1.44269504089f * log1pf(expf(-F.in[I_LAM][DM + ch])); }
    float cf[2] = {0.f, 0.f};
    float gPf[2] = {1.f, 1.f}, gHf[2] = {0.f, 0.f}, gPb[2] = {1.f, 1.f}, gHb[2] = {0.f, 0.f};
    if (PASS == 2) {
#pragma unroll
        for (int nt = 0; nt < 2; ++nt) { const int ch = head * 64 + 32 * nt + col;
            const f32x2* G2 = (const f32x2*)GAGG; const f32x2* A2 = (const f32x2*)AGG;
            int vb = b, vg = g; asm volatile("" : "+v"(vb), "+v"(vg));
            float c = 0.f;
            { f32x2 gf2[16];
#pragma unroll
              for (int gp = 0; gp < 16; ++gp) gf2[gp] = G2[((size_t)((vb * 16 + gp) * DM + ch)) * 2];
#pragma unroll
              for (int gp = 0; gp < 16; ++gp) { if (gp < g) c = gf2[gp].y + gf2[gp].x * c; } }
            cf[nt] = c;
            float cr = 0.f;
            { f32x2 gb2[16], cb2[8];
#pragma unroll
              for (int gp = 0; gp < 16; ++gp) gb2[gp] = G2[((size_t)((vb * 16 + gp) * DM + ch)) * 2 + 1];
#pragma unroll
              for (int k = 0; k < 8; ++k) cb2[k] = A2[((size_t)((vb * 128 + vg * 8 + k) * DM + ch)) * 2 + 1];
#pragma unroll
              for (int gp = 15; gp >= 0; --gp) { if (gp > g) cr = gb2[gp].y + gb2[gp].x * cr; }
#pragma unroll
              for (int k = 7; k >= 0; --k) { if (h == 0) cbuf[k * 64 + 32 * nt + col] = cr; cr = cb2[k].y + cb2[k].x * cr; } }
            asm volatile("" ::: "memory");
        }
        LDS_WAIT();
    }
    u32x4 pre[5];
#define MA_FETCH(tstart) do { _Pragma("unroll") for (int it = 0; it < 5; ++it) { const int rr = it * 8 + (lane >> 3), piece = lane & 7, s = (tstart) - 2 + rr; \
        pre[it] = (u32x4){0u, 0u, 0u, 0u}; \
        if (rr < 35 && s >= 0 && s < SEQ) pre[it] = *(const u32x4*)(AX + ((size_t)(b * SEQ + s)) * DM + head * 64 + piece * 8); } } while (0)
#define MA_COMMIT() do { _Pragma("unroll") for (int it = 0; it < 5; ++it) { const int rr = it * 8 + (lane >> 3), piece = lane & 7; \
        if (rr < 35) *(LAS u32x4*)(raw + rr * 128 + piece * 16) = pre[it]; } } while (0)
    MA_FETCH(g * 256);
    MA_COMMIT();
    MA_FETCH(g * 256 + 32);
    for (int k = 0; k < 8; ++k) {
        const int chunk = g * 8 + k, t0 = chunk * 32;
        LDS_WAIT();
        float xa[2][16];
#pragma unroll
        for (int nt = 0; nt < 2; ++nt)
#pragma unroll
            for (int q = 0; q < 4; ++q) { float rv[7];
#pragma unroll
                for (int e = 0; e < 7; ++e) rv[e] = bf2f(*(const LAS bf16_t*)(raw + (8 * q + 4 * h + e) * 128 + (32 * nt + col) * 2));
#pragma unroll
                for (int e = 0; e < 4; ++e) { const float v = cbias[nt] + cw[nt][0] * rv[e] + cw[nt][1] * rv[e + 1] + cw[nt][2] * rv[e + 2] + cw[nt][3] * rv[e + 3];
                    xa[nt][4 * q + e] = v; *(LAS bf16_t*)(xat + (8 * q + 4 * h + e) * 144 + (32 * nt + col) * 2) = (bf16_t)cvt_pk_bf16(v, v); } }
        LDS_WAIT();
        bf16x8 afr[4];
#pragma unroll
        for (int ks = 0; ks < 4; ++ks) afr[ks] = *(const LAS bf16x8*)(xat + col * 144 + (16 * ks + 8 * h) * 2);
        if (k < 7) { MA_COMMIT(); if (k < 6) MA_FETCH(t0 + 64); }
        if (PASS == 2 && lane < 32) __builtin_amdgcn_global_load_lds((const unsigned*)(GG + ((size_t)(b * SEQ + t0 + lane)) * DM + head * 64), (LAS unsigned*)(scr + 8192), 4, 0, 0);
        float hf[2][16];
#pragma unroll 1
        for (int d = 0; d < 2; ++d) {
#pragma unroll
            for (int nt = 0; nt < 2; ++nt) {
                const float brd = d ? br1[nt] : br0[nt], bid = d ? bi1[nt] : bi0[nt], spd = d ? sp1[nt] : sp0[nt];
                f32x16 ar, aiv;
#pragma unroll
                for (int i = 0; i < 16; ++i) { ar[i] = 0.f; aiv[i] = 0.f; }
#pragma unroll
                for (int ks = 0; ks < 4; ++ks) {
                    const bf16x8 bR = *(const LAS bf16x8*)(WT + ((2 * d + 0) * 64 + 32 * nt + col) * 144 + (16 * ks + 8 * h) * 2);
                    const bf16x8 bI = *(const LAS bf16x8*)(WT + ((2 * d + 1) * 64 + 32 * nt + col) * 144 + (16 * ks + 8 * h) * 2);
                    ar = __builtin_amdgcn_mfma_f32_32x32x16_bf16(afr[ks], bR, ar, 0, 0, 0);
                    aiv = __builtin_amdgcn_mfma_f32_32x32x16_bf16(afr[ks], bI, aiv, 0, 0, 0);
                }
                const float pre0 = aiv[0], pre15 = aiv[15];
#pragma unroll
                for (int i = 0; i < 16; ++i) {
                    const float r = fast_rcp(1.0f + __builtin_amdgcn_exp2f(ar[i] + brd)), ig = fast_rcp(1.0f + __builtin_amdgcn_exp2f(aiv[i] + bid));
                    const float a = __builtin_amdgcn_exp2f(r * spd);
                    const float mult = __builtin_amdgcn_sqrtf(__builtin_fmaf(-a, a, 1.0f));
                    ar[i] = a; aiv[i] = mult * ig * xa[nt][i]; }
                if (t0 == 0 || t0 == SEQ - 32) {
                    if (d == 0 && t0 == 0 && h == 0) aiv[0] = fast_rcp(1.0f + __builtin_amdgcn_exp2f(pre0 + bid)) * xa[nt][0];
                    if (d == 1 && t0 == SEQ - 32 && h == 1) aiv[15] = fast_rcp(1.0f + __builtin_amdgcn_exp2f(pre15 + bid)) * xa[nt][15]; }
            {
                float P[4], H[4], pP[4], pH[4];
#pragma unroll
                for (int q = 0; q < 4; ++q) { float p = 1.f, hh = 0.f;
                    if (d == 0) {
#pragma unroll
                        for (int e = 0; e < 4; ++e) { hh = ar[4 * q + e] * hh + aiv[4 * q + e]; p *= ar[4 * q + e]; }
                    } else {
#pragma unroll
                        for (int e = 3; e >= 0; --e) { hh = ar[4 * q + e] * hh + aiv[4 * q + e]; p *= ar[4 * q + e]; }
                    }
                    P[q] = p; H[q] = hh; pP[q] = __shfl_xor(p, 32); pH[q] = __shfl_xor(hh, 32); }
                float c = (PASS == 2) ? (d == 0 ? cf[nt] : cbuf[k * 64 + 32 * nt + col]) : 0.f;
                float ptot = 1.f, cin[4];
                if (d == 0) {
#pragma unroll
                    for (int q = 0; q < 4; ++q) { const float P1 = h ? pP[q] : P[q], H1 = h ? pH[q] : H[q], P2 = h ? P[q] : pP[q], H2 = h ? H[q] : pH[q];
                        const float c1 = H1 + P1 * c; cin[q] = h ? c1 : c; c = H2 + P2 * c1; ptot *= P1 * P2; }
                } else {
#pragma unroll
                    for (int q = 3; q >= 0; --q) { const float P1 = h ? P[q] : pP[q], H1 = h ? H[q] : pH[q], P2 = h ? pP[q] : P[q], H2 = h ? pH[q] : H[q];
                        const float c1 = H1 + P1 * c; cin[q] = h ? c : c1; c = H2 + P2 * c1; ptot *= P1 * P2; }
                }
                if (PASS == 1) {
                    if (d == 0) { gHf[nt] = c + ptot * gHf[nt]; gPf[nt] *= ptot; cf[nt] = ptot; hf[nt][0] = c; }
                    else { gHb[nt] += gPb[nt] * c; gPb[nt] *= ptot;
                        if (h == 0) AGG[(size_t)(b * 128 + chunk) * DM + head * 64 + 32 * nt + col] = (f32x4){cf[nt], hf[nt][0], ptot, c}; }
                } else {
                    if (d == 0) { cf[nt] = c;
#pragma unroll
                        for (int q = 0; q < 4; ++q) { float hh = cin[q];
#pragma unroll
                            for (int e = 0; e < 4; ++e) { hh = ar[4 * q + e] * hh + aiv[4 * q + e]; ((LAS float*)scr)[(8 * q + 4 * h + e) * 64 + 32 * nt + col] = hh; } }
                    } else {
#pragma unroll
                        for (int q = 0; q < 4; ++q) { float hh = cin[q];
#pragma unroll
                            for (int e = 3; e >= 0; --e) { hh = ar[4 * q + e] * hh + aiv[4 * q + e];
                                LAS float* ps = (LAS float*)scr + (8 * q + 4 * h + e) * 64 + 32 * nt + col; *ps = *ps + hh; } }
                    }
                }
            }
            }
        }
        if (PASS == 2) {
            LDS_WAIT();
            u32x4 gvv[4];
#pragma unroll
            for (int it = 0; it < 4; ++it) gvv[it] = *(const u32x4*)(GG + ((size_t)(b * SEQ + t0 + it * 8 + (lane >> 3))) * DM + head * 64 + (lane & 7) * 8);
#pragma unroll
            for (int it = 0; it < 4; ++it) { const int row = it * 8 + (lane >> 3), piece = lane & 7;
                const f32x4 s0 = *(const LAS f32x4*)(scr + (row * 64 + piece * 8) * 4), s1 = *(const LAS f32x4*)(scr + (row * 64 + piece * 8 + 4) * 4);
                const size_t o = ((size_t)(b * SEQ + t0 + row)) * DM + head * 64 + piece * 8;
                const u32x4 gv = gvv[it];
                u32x4 w; w.x = cvt_pk_bf16(s0.x * bflo(gv.x), s0.y * bfhi(gv.x)); w.y = cvt_pk_bf16(s0.z * bflo(gv.y), s0.w * bfhi(gv.y));
                w.z = cvt_pk_bf16(s1.x * bflo(gv.z), s1.y * bfhi(gv.z)); w.w = cvt_pk_bf16(s1.z * bflo(gv.w), s1.w * bfhi(gv.w));
                *(u32x4*)(UA + o) = w; }
            LDS_WAIT();
        }
    }
#undef MA_FETCH
#undef MA_COMMIT
    if (PASS == 1 && h == 0) {
#pragma unroll
        for (int nt = 0; nt < 2; ++nt) GAGG[(size_t)(b * 16 + g) * DM + head * 64 + 32 * nt + col] = (f32x4){gPf[nt], gHf[nt], gPb[nt], gHb[nt]};
    }
}
template <int PASS>
__device__ __forceinline__ void mixer_a_phase(Frame& F) {
    for (int blk = F.vcu; blk < 256; blk += F.G) {
        const int b = blk >> 5, head = (blk >> 1) & 15, gh = blk & 1;
        __syncthreads();
        mixer_a_load_w(F, head);
        LDS_WAIT(); __syncthreads();
        mixer_a_unit<PASS>(F, b, head, gh * 8 + F.wave);
    }
    __syncthreads();
}

constexpr int HY_PITCH = 10256, HY_PAD = 512, HY_U = 0, HY_C0 = 82176, HY_COPY = 16640, HY_C1 = HY_C0 + HY_COPY + 68, HY_OFFR = 4160, HY_NEL = 8320;
__device__ __forceinline__ int hy_uaddr(int b, int s) { const int e = s + HY_PAD, q = e >> 3; return b * HY_PITCH + ((q ^ (((q >> 4) & 3) << 2)) << 4) + ((e & 7) << 1); }
struct HyU { u32x4 mv[NB]; unsigned pvb[NB], nvb[NB]; };
struct HyF { u32x4 vf, vb; };
__device__ __forceinline__ void hy_fetch_u(Frame& F, int part, int c, HyU& r) {
    const bf16_t* HYT = (const bf16_t*)(F.ws + WS_HYT); const int s0 = 8 * F.tid;
#pragma unroll
    for (int b = 0; b < NB; ++b) { const bf16_t* src = HYT + ((size_t)((part * NB + b) * DM + c)) * SEQ;
        r.mv[b] = *(const u32x4*)(src + s0); r.pvb[b] = s0 > 0 ? (unsigned)src[s0 - 1] : 0u; r.nvb[b] = (s0 + 8 < SEQ) ? (unsigned)src[s0 + 8] : 0u; }
}
__device__ __forceinline__ void hy_commit_u(Frame& F, int part, int c, const HyU& r) {
    const float w0 = F.in[I_CBW][0 * 3072 + part * 1024 + c], w1 = F.in[I_CBW][1 * 3072 + part * 1024 + c], w2 = F.in[I_CBW][2 * 3072 + part * 1024 + c], bb = F.in[I_CBB][part * 1024 + c];
    const int s0 = 8 * F.tid;
#pragma unroll
    for (int b = 0; b < NB; ++b) {
        float x[10]; x[0] = bf2f(r.pvb[b]); x[1] = bflo(r.mv[b].x); x[2] = bfhi(r.mv[b].x); x[3] = bflo(r.mv[b].y); x[4] = bfhi(r.mv[b].y); x[5] = bflo(r.mv[b].z); x[6] = bfhi(r.mv[b].z); x[7] = bflo(r.mv[b].w); x[8] = bfhi(r.mv[b].w); x[9] = bf2f(r.nvb[b]);
        float o[8];
#pragma unroll
        for (int e = 0; e < 8; ++e) o[e] = bb + w0 * x[e] + w1 * x[e + 1] + w2 * x[e + 2];
        *(LAS u32x4*)(F.lds + HY_U + hy_uaddr(b, s0)) = (u32x4){pk2(o[0], o[1]), pk2(o[2], o[3]), pk2(o[4], o[5]), pk2(o[6], o[7])};
    }
}
__device__ __forceinline__ void hy_put(Frame& F, int i, unsigned v) {
    *(LAS bf16_t*)(F.lds + HY_C0 + 2 * (i + HY_OFFR)) = (bf16_t)v;
    *(LAS bf16_t*)(F.lds + HY_C1 + 2 * (i - 1 + HY_OFFR)) = (bf16_t)v;
}
__device__ __forceinline__ void hy_fetch_f(Frame& F, int order, int c, HyF& r) {
    const bf16_t* hf = (const bf16_t*)(F.ws + WS_FG) + ((size_t)((order * 2 + 0) * 1024 + c)) * 4096;
    const bf16_t* hb = (const bf16_t*)(F.ws + WS_FG) + ((size_t)((order * 2 + 1) * 1024 + c)) * 4096;
    r.vf = *(const u32x4*)(hf + 8 * F.tid); r.vb = *(const u32x4*)(hb + 8 * F.tid);
}
__device__ __forceinline__ void hy_commit_f(Frame& F, const HyF& r) {
    const int t0 = 8 * F.tid;
    const unsigned wf[4] = {r.vf.x, r.vf.y, r.vf.z, r.vf.w}, wb[4] = {r.vb.x, r.vb.y, r.vb.z, r.vb.w};
#pragma unroll
    for (int e = 0; e < 8; ++e) { const unsigned f = (wf[e >> 1] >> (16 * (e & 1))) & 0xffffu, bk = (wb[e >> 1] >> (16 * (e & 1))) & 0xffffu; const int t = t0 + e;
        hy_put(F, -t, f);
        if (t > 0) hy_put(F, t, bk); }
}
__device__ __forceinline__ void hy_zero_filter(Frame& F) {
    for (int i = F.tid; i < (HY_C1 + HY_COPY - HY_C0) / 4; i += NTHREADS) *(LAS unsigned*)(F.lds + HY_C0 + 4 * i) = 0u;
}
struct A4 { unsigned x, y, z, w; } __attribute__((aligned(4)));
__device__ __forceinline__ bf16x8 hy_lda(LAS unsigned char* p) { const LAS unsigned* q = (const LAS unsigned*)p; u32x4 v; v.x = q[0]; v.y = q[1]; v.z = q[2]; v.w = q[3]; return __builtin_bit_cast(bf16x8, v); }
__device__ __forceinline__ bf16x8 hy_ldb(LAS unsigned char* ub, int q) { return *(const LAS bf16x8*)(ub + ((q ^ (((q >> 4) & 3) << 2)) << 4)); }
__device__ __forceinline__ void hy_conv(Frame& F, f32x16 (&acc)[4]) {
    const int lane = F.lane, w = F.wave, r = lane & 31, h = lane >> 5, n = lane & 31, bq = n >> 2, ap = n & 3;
#pragma unroll
    for (int j = 0; j < 4; ++j)
#pragma unroll
        for (int i = 0; i < 16; ++i) acc[j][i] = 0.f;
    const int p = r & 1;
    LAS unsigned char* abase = F.lds + (p ? HY_C1 : HY_C0) + 2 * (8 * h - r - p + HY_OFFR) - 2 * (512 * w - 4080);
    LAS unsigned char* ub = F.lds + HY_U + bq * HY_PITCH;
    const int q0 = 16 * ap + 574 + h;
    bf16x8 Bw[2][4];
    Bw[0][3] = hy_ldb(ub, q0 + 4); Bw[0][2] = hy_ldb(ub, q0 + 8); Bw[0][1] = hy_ldb(ub, q0 + 12);
    Bw[1][3] = hy_ldb(ub, q0 + 2); Bw[1][2] = hy_ldb(ub, q0 + 6); Bw[1][1] = hy_ldb(ub, q0 + 10);
    Bw[0][0] = Bw[0][1]; Bw[1][0] = Bw[1][1];
    bf16x8 an = hy_lda(abase), bn = hy_ldb(ub, q0);
    for (int kk = 0; kk < 288; kk += 8) {
#pragma unroll
        for (int u = 0; u < 8; ++u) {
            const int k = kk + u, par = u & 1, slot = u >> 1;
            const bf16x8 a = an; Bw[par][slot] = bn;
            const int k1 = (k + 1 < 288) ? k + 1 : 287;
            an = hy_lda(abase - 32 * k1); bn = hy_ldb(ub, q0 - 2 * k1);
            __builtin_amdgcn_s_setprio(1);
#pragma unroll
            for (int j = 0; j < 4; ++j) acc[j] = __builtin_amdgcn_mfma_f32_32x32x16_bf16(a, Bw[par][(slot - j) & 3], acc[j], 0, 0, 0);
            __builtin_amdgcn_s_setprio(0);
        }
    }
}
__device__ __forceinline__ void hyena_channel(Frame& F, int c, int cnext, bf16_t* UBT, HyU& pu, HyF& pf) {
    const int lane = F.lane, w = F.wave, h = lane >> 5, n = lane & 31, bq = n >> 2, ap = n & 3;
    f32x16 acc[4];
    __syncthreads();
    hy_commit_u(F, 0, c, pu); hy_commit_f(F, pf);
    LDS_WAIT(); __syncthreads();
    hy_fetch_u(F, 1, c, pu); hy_fetch_f(F, 1, c, pf);
    hy_conv(F, acc);
    __syncthreads();
    hy_commit_u(F, 1, c, pu); hy_commit_f(F, pf);
    LDS_WAIT(); __syncthreads();
#pragma unroll
    for (int j = 0; j < 4; ++j)
#pragma unroll
        for (int qd = 0; qd < 4; ++qd) { const int t = 512 * w + 32 * j + 128 * ap + 8 * qd + 4 * h;
            LAS u32x2* pz = (LAS u32x2*)(F.lds + HY_U + hy_uaddr(bq, t)); const u32x2 xv = *pz;
            u32x2 o; o.x = pk2(bflo(xv.x) * acc[j][4 * qd + 0], bfhi(xv.x) * acc[j][4 * qd + 1]); o.y = pk2(bflo(xv.y) * acc[j][4 * qd + 2], bfhi(xv.y) * acc[j][4 * qd + 3]);
            *pz = o; }
    LDS_WAIT(); __syncthreads();
    hy_fetch_u(F, 2, c, pu);
    hy_conv(F, acc);
    __syncthreads();
    hy_commit_u(F, 2, c, pu);
    LDS_WAIT(); __syncthreads();
    if (cnext >= 0) { hy_fetch_u(F, 0, cnext, pu); hy_fetch_f(F, 0, cnext, pf); }
#pragma unroll
    for (int j = 0; j < 4; ++j)
#pragma unroll
        for (int qd = 0; qd < 4; ++qd) { const int t = 512 * w + 32 * j + 128 * ap + 8 * qd + 4 * h;
            const u32x2 xv = *(const LAS u32x2*)(F.lds + HY_U + hy_uaddr(bq, t));
            u32x2 o; o.x = pk2(bflo(xv.x) * acc[j][4 * qd + 0], bfhi(xv.x) * acc[j][4 * qd + 1]); o.y = pk2(bflo(xv.y) * acc[j][4 * qd + 2], bfhi(xv.y) * acc[j][4 * qd + 3]);
            *(u32x2*)(UBT + ((size_t)(bq * DM + c)) * SEQ + t) = o; }
}
__device__ __forceinline__ void hyena_phase(Frame& F, bf16_t* UBT) {
    __syncthreads();
    for (int i = F.tid; i < (NB * HY_PITCH) / 16; i += NTHREADS) *(LAS u32x4*)(F.lds + HY_U + i * 16) = (u32x4){0u, 0u, 0u, 0u};
    hy_zero_filter(F);
    LDS_WAIT(); __syncthreads();
    HyU pu; HyF pf;
    if (F.vcu < DM) { hy_fetch_u(F, 0, F.vcu, pu); hy_fetch_f(F, 0, F.vcu, pf); }
    for (int c = F.vcu; c < DM; c += F.G) hyena_channel(F, c, (c + F.G < DM) ? c + F.G : -1, UBT, pu, pf);
    __syncthreads();
}

constexpr int FU = 0, FW = 65536, FW2 = 98304, FPL = 16384;
#ifndef HYENA_FFT
#define HYENA_FFT 1
#endif
typedef f32x4 facc;
__device__ __forceinline__ facc fmma(bf16x8 a, bf16x8 b) { return __builtin_amdgcn_mfma_f32_16x16x32_bf16(a, b, (facc){0.f, 0.f, 0.f, 0.f}, 0, 0, 0); }
__device__ __forceinline__ facc fmma_acc(bf16x8 a, bf16x8 b, facc c) { return __builtin_amdgcn_mfma_f32_16x16x32_bf16(a, b, c, 0, 0, 0); }
__device__ __forceinline__ bf16x8 dft_frag(int R, float sgn, int joff, int kidx, int g, int part) {
    u32x4 w; unsigned* pw = (unsigned*)&w; const int half = g >> 1; const float rinv = 1.0f / (float)R;
#pragma unroll
    for (int e2 = 0; e2 < 4; ++e2) { float v[2];
#pragma unroll
        for (int q = 0; q < 2; ++q) { const int j = joff + 8 * (g & 1) + 2 * e2 + q; const float f = (float)((j * kidx) & (R - 1)) * rinv;
            const float c = __builtin_amdgcn_cosf(f), sn = sgn * __builtin_amdgcn_sinf(f);
            v[q] = part == 0 ? (half == 0 ? c : -sn) : (half == 0 ? sn : c); }
        pw[e2] = pk2(v[0], v[1]); }
    return __builtin_bit_cast(bf16x8, w);
}
__device__ __forceinline__ bf16x8 ld_frag(LAS unsigned char* base, int elem_off, int g) { return *(const LAS bf16x8*)(base + (g >> 1) * FPL + (elem_off + 8 * (g & 1)) * 2); }
__device__ __forceinline__ void st_quad(LAS unsigned char* base, int elem_off, const float (&re)[4], const float (&im)[4]) {
    *(LAS u32x2*)(base + elem_off * 2) = (u32x2){cvt_pk_bf16(re[0], re[1]), cvt_pk_bf16(re[2], re[3])};
    *(LAS u32x2*)(base + FPL + elem_off * 2) = (u32x2){cvt_pk_bf16(im[0], im[1]), cvt_pk_bf16(im[2], im[3])};
}
__device__ __forceinline__ void twid(float& re, float& im, int num, int den_mask, float den_inv, float sgn) {
    const float f = (float)(num & den_mask) * den_inv; const float c = __builtin_amdgcn_cosf(f), sn = sgn * __builtin_amdgcn_sinf(f);
    const float r2 = __builtin_fmaf(re, c, -(im * sn)), i2 = __builtin_fmaf(re, sn, im * c); re = r2; im = i2;
}
constexpr int FTAB = 131072;
__device__ __forceinline__ bf16x8 tab_frag(Frame& F, int id) { return *(const LAS bf16x8*)(F.lds + FTAB + (id * 64 + F.lane) * 16); }
__device__ __forceinline__ void fft_build_table(Frame& F) {
    const int idx = F.lane & 15, g = F.lane >> 4;
    for (int id = 2 * F.wave; id < 2 * F.wave + 2; ++id) { bf16x8 v;
        if (id < 2) v = dft_frag(16, -1.f, 0, idx, g, id & 1);
        else if (id < 4) v = dft_frag(16, 1.f, 0, idx, g, id & 1);
        else if (id < 8) v = dft_frag(32, -1.f, 0, 16 * ((id >> 1) & 1) + idx, g, id & 1);
        else if (id < 12) v = dft_frag(32, 1.f, 16 * (id & 1), idx, g, (id >> 1) & 1);
        else v = dft_frag(32, -1.f, 16, 16 * ((id >> 1) & 1) + idx, g, id & 1);
        *(LAS bf16x8*)(F.lds + FTAB + (id * 64 + F.lane) * 16) = v; }
}
__device__ __forceinline__ void twid4(float (&re)[4], float (&im)[4], int base, int step, int den_mask, float den_inv, float sgn) {
    const float fb = (float)(base & den_mask) * den_inv, fs = (float)(step & den_mask) * den_inv;
    float c = __builtin_amdgcn_cosf(fb), sn = sgn * __builtin_amdgcn_sinf(fb);
    const float cs = __builtin_amdgcn_cosf(fs), ss = sgn * __builtin_amdgcn_sinf(fs);
#pragma unroll
    for (int r = 0; r < 4; ++r) {
        const float r2 = __builtin_fmaf(re[r], c, -(im[r] * sn)), i2 = __builtin_fmaf(re[r], sn, im[r] * c); re[r] = r2; im[r] = i2;
        if (r < 3) { const float c2 = __builtin_fmaf(c, cs, -(sn * ss)), s2 = __builtin_fmaf(c, ss, sn * cs); c = c2; sn = s2; } }
}
template <int NA>
__device__ __forceinline__ void fft_s1(Frame& F, LAS unsigned char* inre, LAS unsigned char* inim, bool imzero) {
    const int lane = F.lane, idx = lane & 15, g = lane >> 4; LAS unsigned char* W = F.lds + FW;
    bf16x8 B[2][2][NA];
#pragma unroll
    for (int hi = 0; hi < 2; ++hi)
#pragma unroll
        for (int part = 0; part < 2; ++part)
#pragma unroll
            for (int sa = 0; sa < NA; ++sa) B[hi][part][sa] = tab_frag(F, (sa ? 12 : 4) + 2 * hi + part);
#pragma unroll
    for (int tq = 0; tq < 2; ++tq) { const int tc = 2 * F.wave + tq;
        bf16x8 A[NA];
#pragma unroll
        for (int sa = 0; sa < NA; ++sa) { const int eo = ((tc * 16 + idx) * (16 * NA)) + 16 * sa + 8 * (g & 1);
            u32x4 z = (u32x4){0u, 0u, 0u, 0u};
            if (g < 2) z = *(const LAS u32x4*)(inre + eo * 2); else if (!imzero) z = *(const LAS u32x4*)(inim + eo * 2);
            A[sa] = __builtin_bit_cast(bf16x8, z); }
#pragma unroll
        for (int hi = 0; hi < 2; ++hi) { facc cr = (facc){0.f, 0.f, 0.f, 0.f}, ci = cr;
#pragma unroll
            for (int sa = 0; sa < NA; ++sa) { cr = fmma_acc(A[sa], B[hi][0][sa], cr); ci = fmma_acc(A[sa], B[hi][1][sa], ci); }
            const int ka = 16 * hi + idx; float re[4], im[4];
#pragma unroll
            for (int r = 0; r < 4; ++r) { re[r] = cr[r]; im[r] = ci[r]; }
            twid4(re, im, 4 * g * ka, ka, 511, 1.0f / 512.0f, -1.f);
            st_quad(W, (ka * 16 + tc) * 16 + 4 * g, re, im); }
    }
}
__device__ __forceinline__ void fft_s2(Frame& F) {
    const int lane = F.lane, idx = lane & 15, g = lane >> 4; LAS unsigned char* W = F.lds + FW;
    const bf16x8 Br = tab_frag(F, 0), Bi = tab_frag(F, 1);
#pragma unroll 2
    for (int kq = 0; kq < 4; ++kq) { const int ka = 4 * F.wave + kq;
        const bf16x8 A = ld_frag(W, (ka * 16 + idx) * 16, g);
        const facc cr = fmma(A, Br), ci = fmma(A, Bi);
        float re[4], im[4];
#pragma unroll
        for (int r = 0; r < 4; ++r) { re[r] = cr[r]; im[r] = ci[r]; }
            twid4(re, im, 4 * g * (ka + 32 * idx), ka + 32 * idx, 8191, 1.0f / 8192.0f, -1.f);
        st_quad(W, (ka * 16 + idx) * 16 + 4 * g, re, im);
    }
}
template <int MODE>
__device__ __forceinline__ void fft_s3(Frame& F, unsigned* KH) {
    const int lane = F.lane, idx = lane & 15, g = lane >> 4; LAS unsigned char* W = F.lds + FW;
    const bf16x8 Ar = tab_frag(F, 0), Ai = tab_frag(F, 1);
#pragma unroll 2
    for (int kq = 0; kq < 4; ++kq) { const int ka = 4 * F.wave + kq;
        const bf16x8 Bd = ld_frag(W, (ka * 16 + idx) * 16, g);
        const facc cr = fmma(Ar, Bd), ci = fmma(Ai, Bd);
        const int eo = (ka * 16 + idx) * 16 + 4 * g;
        if (MODE == 1) { u32x4 o; o.x = pk2(cr[0], ci[0]); o.y = pk2(cr[1], ci[1]); o.z = pk2(cr[2], ci[2]); o.w = pk2(cr[3], ci[3]); *(u32x4*)(KH + eo) = o; }
        else { const u32x4 kv = *(const u32x4*)(KH + eo); const unsigned kw[4] = {kv.x, kv.y, kv.z, kv.w}; float re[4], im[4];
#pragma unroll
            for (int r = 0; r < 4; ++r) { const float kr = bflo(kw[r]), ki = bfhi(kw[r]); re[r] = __builtin_fmaf(cr[r], kr, -(ci[r] * ki)); im[r] = __builtin_fmaf(cr[r], ki, ci[r] * kr); }
            st_quad(W, eo, re, im); }
    }
}
__device__ __forceinline__ void fft_i1(Frame& F) {
    const int lane = F.lane, idx = lane & 15, g = lane >> 4; LAS unsigned char* W = F.lds + FW;
    const bf16x8 Br = tab_frag(F, 2), Bi = tab_frag(F, 3);
#pragma unroll 2
    for (int kq = 0; kq < 4; ++kq) { const int ka = 4 * F.wave + kq;
        const bf16x8 A = ld_frag(W, (ka * 16 + idx) * 16, g);
        const facc cr = fmma(A, Br), ci = fmma(A, Bi);
        float re[4], im[4];
#pragma unroll
        for (int r = 0; r < 4; ++r) { re[r] = cr[r]; im[r] = ci[r]; }
            twid4(re, im, idx * (ka + 128 * g), 32 * idx, 8191, 1.0f / 8192.0f, 1.f);
        st_quad(W, (ka * 16 + idx) * 16 + 4 * g, re, im);
    }
}
__device__ __forceinline__ void fft_mid(Frame& F, const unsigned* KH) {
    const int lane = F.lane, idx = lane & 15, g = lane >> 4; LAS unsigned char* W = F.lds + FW;
    const bf16x8 Fr = tab_frag(F, 0), Fi = tab_frag(F, 1), Gr = tab_frag(F, 2), Gi = tab_frag(F, 3);
#pragma unroll 1
    for (int kp = 0; kp < 2; ++kp) {
        const int ka0 = 4 * F.wave + 2 * kp, eb0 = (ka0 * 16 + idx) * 16, eb1 = eb0 + 256, eo0 = eb0 + 4 * g, eo1 = eb1 + 4 * g;
        const u32x4 kv0 = *(const u32x4*)(KH + eo0), kv1 = *(const u32x4*)(KH + eo1);
        float re[4], im[4];
        {
            const bf16x8 A0 = ld_frag(W, eb0, g), A1 = ld_frag(W, eb1, g);
            const facc cr0 = fmma(A0, Fr), ci0 = fmma(A0, Fi), cr1 = fmma(A1, Fr), ci1 = fmma(A1, Fi);
            __builtin_amdgcn_sched_barrier(0);
#pragma unroll
            for (int r = 0; r < 4; ++r) { re[r] = cr0[r]; im[r] = ci0[r]; }
            twid4(re, im, 4 * g * (ka0 + 32 * idx), ka0 + 32 * idx, 8191, 1.0f / 8192.0f, -1.f); st_quad(W, eo0, re, im);
#pragma unroll
            for (int r = 0; r < 4; ++r) { re[r] = cr1[r]; im[r] = ci1[r]; }
            twid4(re, im, 4 * g * (ka0 + 1 + 32 * idx), ka0 + 1 + 32 * idx, 8191, 1.0f / 8192.0f, -1.f); st_quad(W, eo1, re, im); }
        LDS_ORDER();
        {
            const bf16x8 B0 = ld_frag(W, eb0, g), B1 = ld_frag(W, eb1, g);
            const facc cr0 = fmma(Fr, B0), ci0 = fmma(Fi, B0), cr1 = fmma(Fr, B1), ci1 = fmma(Fi, B1);
            __builtin_amdgcn_sched_barrier(0);
            const unsigned kw0[4] = {kv0.x, kv0.y, kv0.z, kv0.w}, kw1[4] = {kv1.x, kv1.y, kv1.z, kv1.w};
#pragma unroll
            for (int r = 0; r < 4; ++r) { const float kr = bflo(kw0[r]), ki = bfhi(kw0[r]); re[r] = __builtin_fmaf(cr0[r], kr, -(ci0[r] * ki)); im[r] = __builtin_fmaf(cr0[r], ki, ci0[r] * kr); }
            st_quad(W, eo0, re, im);
#pragma unroll
            for (int r = 0; r < 4; ++r) { const float kr = bflo(kw1[r]), ki = bfhi(kw1[r]); re[r] = __builtin_fmaf(cr1[r], kr, -(ci1[r] * ki)); im[r] = __builtin_fmaf(cr1[r], ki, ci1[r] * kr); }
            st_quad(W, eo1, re, im); }
        LDS_ORDER();
        {
            const bf16x8 A0 = ld_frag(W, eb0, g), A1 = ld_frag(W, eb1, g);
            const facc cr0 = fmma(A0, Gr), ci0 = fmma(A0, Gi), cr1 = fmma(A1, Gr), ci1 = fmma(A1, Gi);
            __builtin_amdgcn_sched_barrier(0);
#pragma unroll
            for (int r = 0; r < 4; ++r) { re[r] = cr0[r]; im[r] = ci0[r]; }
            twid4(re, im, idx * (ka0 + 128 * g), 32 * idx, 8191, 1.0f / 8192.0f, 1.f); st_quad(W, eo0, re, im);
#pragma unroll
            for (int r = 0; r < 4; ++r) { re[r] = cr1[r]; im[r] = ci1[r]; }
            twid4(re, im, idx * (ka0 + 1 + 128 * g), 32 * idx, 8191, 1.0f / 8192.0f, 1.f); st_quad(W, eo1, re, im); }
        LDS_ORDER();
    }
}
__device__ __forceinline__ void fft_i2(Frame& F) {
    const int lane = F.lane, idx = lane & 15, g = lane >> 4; LAS unsigned char* W = F.lds + FW; LAS unsigned char* W2 = F.lds + FW2;
    const bf16x8 Br = tab_frag(F, 2), Bi = tab_frag(F, 3);
#pragma unroll 2
    for (int tq = 0; tq < 4; ++tq) { const int t = 4 * F.wave + tq, c = t >> 1, hi = t & 1;
        const bf16x8 A = ld_frag(W, ((16 * hi + idx) * 16 + c) * 16, g);
        const facc cr = fmma(A, Br), ci = fmma(A, Bi);
        float re[4], im[4];
#pragma unroll
        for (int r = 0; r < 4; ++r) { re[r] = cr[r]; im[r] = ci[r]; }
        twid4(re, im, idx * (16 * hi + 4 * g), idx, 511, 1.0f / 512.0f, 1.f);
        st_quad(W2, (c * 16 + idx) * 32 + 16 * hi + 4 * g, re, im);
    }
}
__device__ __forceinline__ void fft_i3_tile(Frame& F, int b, const bf16x8 (&B)[2][2], float (&yre)[4], float (&yim)[4]) {
    const int lane = F.lane, idx = lane & 15, g = lane >> 4; LAS unsigned char* W2 = F.lds + FW2;
    facc cr = (facc){0.f, 0.f, 0.f, 0.f}, ci = cr;
#pragma unroll
    for (int sa = 0; sa < 2; ++sa) { const bf16x8 A = ld_frag(W2, (idx * 16 + b) * 32 + 16 * sa, g); cr = fmma_acc(A, B[0][sa], cr); ci = fmma_acc(A, B[1][sa], ci); }
#pragma unroll
    for (int r = 0; r < 4; ++r) { yre[r] = cr[r] * (1.0f / 8192.0f); yim[r] = ci[r] * (1.0f / 8192.0f); }
}
__device__ __forceinline__ void fft_load_kernel(Frame& F, int order, int ch) {
    const bf16_t* hf = (const bf16_t*)(F.ws + WS_FG) + ((size_t)((order * 2 + 0) * 1024 + ch)) * 4096;
    const bf16_t* hb = (const bf16_t*)(F.ws + WS_FG) + ((size_t)((order * 2 + 1) * 1024 + ch)) * 4096;
    LAS bf16_t* K = (LAS bf16_t*)(F.lds + FW2);
    const int t0 = 8 * F.tid; const u32x4 vf = *(const u32x4*)(hf + t0), vb = *(const u32x4*)(hb + t0);
    const unsigned wf[4] = {vf.x, vf.y, vf.z, vf.w}, wb[4] = {vb.x, vb.y, vb.z, vb.w};
#pragma unroll
    for (int e = 0; e < 8; ++e) { const int t = t0 + e; const unsigned f = (wf[e >> 1] >> (16 * (e & 1))) & 0xffffu, bk = (wb[e >> 1] >> (16 * (e & 1))) & 0xffffu;
        { const int m = t; K[(((m & 15) * 16 + ((m >> 4) & 15)) * 32) + (m >> 8)] = (bf16_t)f; }
        { const int m = (8192 - t) & 8191; const unsigned v = t == 0 ? f : bk; if (t != 0) K[(((m & 15) * 16 + ((m >> 4) & 15)) * 32) + (m >> 8)] = (bf16_t)v; } }
    if (F.tid == 0) { const int m = 4096; K[(((m & 15) * 16 + ((m >> 4) & 15)) * 32) + (m >> 8)] = (bf16_t)0; }
}
__device__ __forceinline__ void fft_commit_u(Frame& F, int c, const HyU& r) {
    const float w0 = F.in[I_CBW][0 * 3072 + c], w1 = F.in[I_CBW][1 * 3072 + c], w2 = F.in[I_CBW][2 * 3072 + c], bb = F.in[I_CBB][c];
    const int s0 = 8 * F.tid, a = s0 >> 8, b4 = (s0 >> 4) & 15, c0 = s0 & 15;
#pragma unroll
    for (int b = 0; b < NB; ++b) {
        float x[10]; x[0] = bf2f(r.pvb[b]); x[1] = bflo(r.mv[b].x); x[2] = bfhi(r.mv[b].x); x[3] = bflo(r.mv[b].y); x[4] = bfhi(r.mv[b].y); x[5] = bflo(r.mv[b].z); x[6] = bfhi(r.mv[b].z); x[7] = bflo(r.mv[b].w); x[8] = bfhi(r.mv[b].w); x[9] = bf2f(r.nvb[b]);
        LAS bf16_t* row = (LAS bf16_t*)(F.lds + FU + b * 8192);
#pragma unroll
        for (int e = 0; e < 8; e += 2) { const unsigned zz = cvt_pk_bf16(bb + w0 * x[e] + w1 * x[e + 1] + w2 * x[e + 2], bb + w0 * x[e + 1] + w1 * x[e + 2] + w2 * x[e + 3]);
            row[((c0 + e) * 16 + b4) * 16 + a] = (bf16_t)zz; row[((c0 + e + 1) * 16 + b4) * 16 + a] = (bf16_t)(zz >> 16); }
    }
}
struct GateRaw { u32x2 mv; bf16_t pv, nv; };
__device__ __forceinline__ void fft_gate_load(Frame& F, int part, int batch, int c, int t, GateRaw& q) {
    const bf16_t* src = (const bf16_t*)(F.ws + WS_HYT) + ((size_t)((part * NB + batch) * DM + c)) * SEQ;
    q.mv = *(const u32x2*)(src + t); q.pv = src[t > 0 ? t - 1 : 0]; q.nv = src[(t + 4 < SEQ) ? t + 4 : SEQ - 1];
}
__device__ __forceinline__ void fft_gate_eval(const GateRaw& q, int t, float w0, float w1, float w2, float bb, float (&gq)[4]) {
    const float pv = t > 0 ? bf2f(q.pv) : 0.f, nv = (t + 4 < SEQ) ? bf2f(q.nv) : 0.f;
    const float x[6] = {pv, bflo(q.mv.x), bfhi(q.mv.x), bflo(q.mv.y), bfhi(q.mv.y), nv};
#pragma unroll
    for (int e = 0; e < 4; ++e) gq[e] = bb + w0 * x[e] + w1 * x[e + 1] + w2 * x[e + 2];
}
__device__ __forceinline__ void hyena_channel_fft(Frame& F, int c, int it, int cnext, bf16_t* UBT, HyU& pu) {
    const int lane = F.lane, idx = lane & 15, g = lane >> 4;
    unsigned* KHbase = (unsigned*)(F.ws + 456 * MiB) + ((size_t)blockIdx.x * 8 + it * 2) * 8192;
    __syncthreads();
    fft_commit_u(F, c, pu);
    if (cnext >= 0) hy_fetch_u(F, 0, cnext, pu);
    bf16x8 B3[2][2];
#pragma unroll
    for (int part = 0; part < 2; ++part)
#pragma unroll
        for (int sa = 0; sa < 2; ++sa) B3[part][sa] = tab_frag(F, 8 + 2 * part + sa);
    for (int order = 0; order < 2; ++order) {
        unsigned* KH = KHbase + order * 8192;
        const int gp = 1 + order;
        const float w0 = F.in[I_CBW][0 * 3072 + gp * 1024 + c], w1 = F.in[I_CBW][1 * 3072 + gp * 1024 + c], w2 = F.in[I_CBW][2 * 3072 + gp * 1024 + c], bb = F.in[I_CBB][gp * 1024 + c];
        __syncthreads();
        fft_load_kernel(F, order, c);
        LDS_WAIT(); __syncthreads();
        fft_s1<2>(F, F.lds + FW2, F.lds + FW2, true);
        LDS_WAIT(); __syncthreads();
        fft_s2(F);
        LDS_WAIT(); __syncthreads();
        fft_s3<1>(F, KH);
        VM_WAIT(); __syncthreads();
        for (int p = 0; p < 4; ++p) {
            fft_s1<1>(F, F.lds + FU + (2 * p) * 8192, F.lds + FU + (2 * p + 1) * 8192, false);
            LDS_WAIT(); __syncthreads();
            fft_mid(F, KH);
            LDS_WAIT(); __syncthreads();
            GateRaw gq[2][2];
#pragma unroll
            for (int bq = 0; bq < 2; ++bq) { const int t = 256 * idx + 16 * (2 * F.wave + bq) + 4 * g; fft_gate_load(F, gp, 2 * p, c, t, gq[bq][0]); fft_gate_load(F, gp, 2 * p + 1, c, t, gq[bq][1]); }
            __builtin_amdgcn_sched_barrier(0);
            fft_i2(F);
            LDS_WAIT(); __syncthreads();
#pragma unroll
            for (int bq = 0; bq < 2; ++bq) { const int b = 2 * F.wave + bq;
                float yre[4], yim[4], g0[4], g1[4];
                const int t = 256 * idx + 16 * b + 4 * g;
                fft_i3_tile(F, b, B3, yre, yim);
                fft_gate_eval(gq[bq][0], t, w0, w1, w2, bb, g0); fft_gate_eval(gq[bq][1], t, w0, w1, w2, bb, g1);
                if (order == 0) {
                    LAS bf16_t* r0 = (LAS bf16_t*)(F.lds + FU + (2 * p) * 8192); LAS bf16_t* r1 = (LAS bf16_t*)(F.lds + FU + (2 * p + 1) * 8192);
#pragma unroll
                    for (int r = 0; r < 4; ++r) { const int eo = ((4 * g + r) * 16 + b) * 16 + idx; const unsigned zz = cvt_pk_bf16(g0[r] * yre[r], g1[r] * yim[r]); r0[eo] = (bf16_t)zz; r1[eo] = (bf16_t)(zz >> 16); }
                } else {
                    *(u32x2*)(UBT + ((size_t)((2 * p) * DM + c)) * SEQ + t) = (u32x2){cvt_pk_bf16(g0[0] * yre[0], g0[1] * yre[1]), cvt_pk_bf16(g0[2] * yre[2], g0[3] * yre[3])};
                    *(u32x2*)(UBT + ((size_t)((2 * p + 1) * DM + c)) * SEQ + t) = (u32x2){cvt_pk_bf16(g1[0] * yim[0], g1[1] * yim[1]), cvt_pk_bf16(g1[2] * yim[2], g1[3] * yim[3])};
                }
            }
            LDS_WAIT(); __syncthreads();
        }
    }
}
__device__ __forceinline__ void hyena_phase_fft(Frame& F, bf16_t* UBT) {
    __syncthreads();
    fft_build_table(F);
    LDS_WAIT(); __syncthreads();
    HyU pu;
    if (F.vcu < DM) hy_fetch_u(F, 0, F.vcu, pu);
    int it = 0;
    for (int c = F.vcu; c < DM; c += F.G, ++it) hyena_channel_fft(F, c, it & 3, (c + F.G < DM) ? c + F.G : -1, UBT, pu);
    __syncthreads();
}
__device__ __forceinline__ void ub_transpose_phase(Frame& F) {
    const bf16_t* UBT = (const bf16_t*)(F.ws + WS_HYT); bf16_t* UB = (bf16_t*)(F.ws + WS_HYT + 64 * MiB);
    LAS bf16_t* tile = (LAS bf16_t*)(F.lds + F.wave * 16384);
    const int gw = F.vcu * NWAVES + F.wave, NGW = F.G * NWAVES, lane = F.lane;
    for (int it = gw; it < NB * 16 * 64; it += NGW) {
        const int b = it >> 10, cb = (it >> 6) & 15, sb = it & 63, c0 = cb * 64, s0 = sb * 64;
#pragma unroll
        for (int i = 0; i < 8; ++i) { const int cl = i * 8 + (lane >> 3), pp = lane & 7;
            const u32x4 v = *(const u32x4*)(UBT + ((size_t)(b * DM + c0 + cl)) * SEQ + s0 + 8 * pp);
            const unsigned wv[4] = {v.x, v.y, v.z, v.w};
#pragma unroll
            for (int e = 0; e < 8; ++e) tile[(8 * pp + e) * 66 + cl] = (bf16_t)((wv[e >> 1] >> (16 * (e & 1))) & 0xffffu); }
        LDS_WAIT();
#pragma unroll
        for (int i = 0; i < 8; ++i) { const int sl = i * 8 + (lane >> 3), pp = lane & 7;
            const LAS unsigned* src = (const LAS unsigned*)(tile + sl * 66 + 8 * pp);
            u32x4 v; v.x = src[0]; v.y = src[1]; v.z = src[2]; v.w = src[3];
            *(u32x4*)(UB + ((size_t)(b * SEQ + s0 + sl)) * DM + c0 + 8 * pp) = v; }
        LDS_WAIT();
    }
}

__device__ __forceinline__ void topk_wave(Frame& F, int b, int e);
constexpr int RT_WR = 0, RT_SCR = 65536;
__device__ __forceinline__ void router_row(Frame& F, int m, const float (&gf)[16], const u32x2 (&vin)[4]) {
    const LAS float* wrT = (const LAS float*)(F.lds + RT_WR);
    f32x4 v[4]; float s = 0.f;
#pragma unroll
    for (int j = 0; j < 4; ++j) { v[j] = bf4(vin[j]); s += (v[j].x * v[j].x + v[j].y * v[j].y) + (v[j].z * v[j].z + v[j].w * v[j].w); }
    s = wave_sum(s);
    const float rstd = 1.0f / sqrtf(s * (1.0f / DM) + EPS);
    unsigned* o4 = (unsigned*)(F.ws + WS_H2 + (size_t)m * DM) + F.lane;
#pragma unroll
    for (int j = 0; j < 4; ++j) { v[j].x *= rstd * gf[4 * j + 0]; v[j].y *= rstd * gf[4 * j + 1]; v[j].z *= rstd * gf[4 * j + 2]; v[j].w *= rstd * gf[4 * j + 3];
        o4[64 * j] = pk4_fp8(fp8_clamp(v[j].x), fp8_clamp(v[j].y), fp8_clamp(v[j].z), fp8_clamp(v[j].w)); }
    float acc[16];
#pragma unroll
    for (int e = 0; e < 16; ++e) { float a = 0.f;
#pragma unroll
        for (int j = 0; j < 4; ++j) { const f32x4 wv = *(const LAS f32x4*)(wrT + e * 1024 + 256 * j + 4 * F.lane); a += (v[j].x * wv.x + v[j].y * wv.y) + (v[j].z * wv.z + v[j].w * wv.w); }
        acc[e] = a; if ((e & 3) == 3) asm volatile("" ::: "memory"); }
    const int lane = F.lane; float r8[8], r4[4], r2[2], lgt;
    { const bool up = (lane & 32) != 0;
#pragma unroll
      for (int i = 0; i < 8; ++i) { const float keep = up ? acc[i + 8] : acc[i], send = up ? acc[i] : acc[i + 8]; r8[i] = keep + __shfl_xor(send, 32); } }
    { const bool up = (lane & 16) != 0;
#pragma unroll
      for (int i = 0; i < 4; ++i) { const float keep = up ? r8[i + 4] : r8[i], send = up ? r8[i] : r8[i + 4]; r4[i] = keep + __shfl_xor(send, 16); } }
    { const bool up = (lane & 8) != 0;
#pragma unroll
      for (int i = 0; i < 2; ++i) { const float keep = up ? r4[i + 2] : r4[i], send = up ? r4[i] : r4[i + 2]; r2[i] = keep + __shfl_xor(send, 8); } }
    { const bool up = (lane & 4) != 0; const float keep = up ? r2[1] : r2[0], send = up ? r2[0] : r2[1]; lgt = keep + __shfl_xor(send, 4); }
    lgt += __shfl_xor(lgt, 2); lgt += __shfl_xor(lgt, 1);
    float mx = lgt;
#pragma unroll
    for (int o = 4; o < 64; o <<= 1) mx = fmaxf(mx, __shfl_xor(mx, o));
    const float p = expf(lgt - mx); float den = p;
#pragma unroll
    for (int o = 4; o < 64; o <<= 1) den += __shfl_xor(den, o);
    if ((lane & 3) == 0) { const int ex = ((lane >> 5) & 1) * 8 + ((lane >> 4) & 1) * 4 + ((lane >> 3) & 1) * 2 + ((lane >> 2) & 1);
        const int b = m >> 12, sq = m & 4095; ((float*)(F.ws + WS_AFF))[(size_t)(b * 16 + ex) * SEQ + sq] = p / den; }
}
__device__ __forceinline__ void phase6(Frame& F) {
    LAS float* wrT = (LAS float*)(F.lds + RT_WR);
    __syncthreads();
    for (int idx = F.tid; idx < 16384; idx += NTHREADS) wrT[(idx & 15) * 1024 + (idx >> 4)] = F.in[I_WROUTER][idx];
    LDS_WAIT(); __syncthreads();
    float gf[16];
#pragma unroll
    for (int j = 0; j < 4; ++j) { const f32x4 g4 = *((const f32x4*)F.in[I_GFFN] + 64 * j + F.lane); gf[4 * j] = g4.x; gf[4 * j + 1] = g4.y; gf[4 * j + 2] = g4.z; gf[4 * j + 3] = g4.w; }
#pragma unroll
    for (int j = 0; j < 16; ++j) asm volatile("" : "+v"(gf[j]));
    const int gw = F.vcu * NWAVES + F.wave, NGW = F.G * NWAVES;
    constexpr int I_GU = (DM / 64) * (DFF / 64), I_DN = (DFF / 64) * (DM / 64), I_ALL = NEXP * (2 * I_GU + I_DN);
    const bool tk = (gw & 15) == 0; const int cw = gw - (gw >> 4) - 1, NCW = NGW - (NGW >> 4);
    int it0 = tk ? (1 << 30) : cw;
#define P6_DECODE(q, it0_) do { const int it_ = REPS(13) > 1 ? (it0_) % I_ALL : (it0_); const int e_ = it_ / (2 * I_GU + I_DN); int r_ = it_ % (2 * I_GU + I_DN); \
        if (r_ < I_GU) { q.W = F.in[I_WGATE] + (size_t)e_ * DM * DFF; q.K = DM; q.N = DFF; q.WT = F.ws + WS_WGU + (size_t)e_ * 4096 * DM; q.mode = 1; q.off = 0; q.item = r_; } \
        else if (r_ < 2 * I_GU) { q.W = F.in[I_WUP] + (size_t)e_ * DM * DFF; q.K = DM; q.N = DFF; q.WT = F.ws + WS_WGU + (size_t)e_ * 4096 * DM; q.mode = 1; q.off = 128; q.item = r_ - I_GU; } \
        else { q.W = F.in[I_WDOWN] + (size_t)e_ * DFF * DM; q.K = DFF; q.N = DM; q.WT = F.ws + WS_WD + (size_t)e_ * DM * DFF; q.mode = 0; q.off = 0; q.item = r_ - 2 * I_GU; } } while (0)
    { u32x2 cur[4], nxt[4]; const bf16_t* XM = (const bf16_t*)(F.ws + WS_XMID);
      if (gw < NT) row_load_bf(XM, gw, F.lane, cur);
      for (int m = gw; m < NT; m += NGW) {
#pragma unroll
          for (int j = 0; j < 4; ++j) nxt[j] = cur[j];
          if (m + NGW < NT) row_load_bf(XM, m + NGW, F.lane, nxt);
          const bool has = it0 < I_ALL * REPS(13);
          F8Item q; f32x4 wv[16];
          if (has) { P6_DECODE(q, it0); f8_issue(q, F.lane, wv); }
          router_row(F, m, gf, cur);
          if (has) { f8_finish(q, F.lane, wv); it0 += NCW; }
#pragma unroll
          for (int j = 0; j < 4; ++j) cur[j] = nxt[j]; } }
    unsigned* rows_done = (unsigned*)(F.ws + WS_CTL) + 8192;
    VM_WAIT(); __syncthreads();
    if (F.tid == 0) { __builtin_amdgcn_fence(__ATOMIC_RELEASE, "agent"); asm volatile("s_waitcnt vmcnt(0)" ::: "memory"); (void)__hip_atomic_fetch_add(rows_done, 1u, __ATOMIC_RELAXED, __HIP_MEMORY_SCOPE_AGENT); }
    for (; it0 < I_ALL * REPS(13); it0 += NCW) { F8Item q; f32x4 wv[16]; P6_DECODE(q, it0); f8_issue(q, F.lane, wv); f8_finish(q, F.lane, wv); }
#undef P6_DECODE
    if ((gw & 15) == 0) {
        unsigned sp = 0; unsigned* tmo = (unsigned*)(F.ws + WS_CTL) + 4096 + XB_TMO;
        while ((unsigned)__builtin_amdgcn_readfirstlane((int)__hip_atomic_load(rows_done, __ATOMIC_RELAXED, __HIP_MEMORY_SCOPE_AGENT)) < (unsigned)F.G) {
            __builtin_amdgcn_s_sleep(2); if (++sp > XB_SPIN_CAP) { if (F.lane == 0) atomicAdd(tmo, 1u); break; } }
        __builtin_amdgcn_fence(__ATOMIC_ACQUIRE, "agent"); asm volatile("s_waitcnt vmcnt(0)" ::: "memory");
        for (int p = gw >> 4; p < NB * NEXP; p += NGW >> 4) topk_wave(F, p >> 4, p & 15);
    }
    __syncthreads();
}
__device__ __forceinline__ int block_excl_scan(Frame& F, int x, LAS int* red, int* tot) {
    int inc = x;
#pragma unroll
    for (int o = 1; o < 64; o <<= 1) { const int y = __shfl_up(inc, o); if (F.lane >= o) inc += y; }
    __syncthreads();
    if (F.lane == 63) red[F.wave] = inc;
    LDS_WAIT(); __syncthreads();
    int base = 0, t = 0;
#pragma unroll
    for (int wv = 0; wv < NWAVES; ++wv) { const int c = red[wv]; if (wv < F.wave) base += c; t += c; }
    *tot = t;
    return base + inc - x;
}
__device__ __forceinline__ void topk_block(Frame& F, int b, int e) {
    LAS int* red = (LAS int*)(F.lds);
    const float* aff = (const float*)(F.ws + WS_AFF) + (size_t)(b * 16 + e) * SEQ + 8 * F.tid;
    const f32x4 v0 = *(const f32x4*)aff, v1 = *(const f32x4*)(aff + 4);
    const float v[8] = {v0.x, v0.y, v0.z, v0.w, v1.x, v1.y, v1.z, v1.w};
    unsigned u[8];
#pragma unroll
    for (int i = 0; i < 8; ++i) u[i] = __builtin_bit_cast(unsigned, v[i]);
    unsigned prefix = 0;
    __syncthreads();
    for (int bit = 30; bit >= 0; --bit) {
        const unsigned cand = prefix | (1u << bit); int cnt = 0;
#pragma unroll
        for (int i = 0; i < 8; ++i) cnt += (u[i] >= cand) ? 1 : 0;
#pragma unroll
        for (int o = 1; o < 64; o <<= 1) cnt += __shfl_xor(cnt, o);
        if (F.lane == 0) red[(bit & 1) * 8 + F.wave] = cnt;
        LDS_WAIT(); __syncthreads();
        int tot = 0;
#pragma unroll
        for (int wv = 0; wv < NWAVES; ++wv) tot += red[(bit & 1) * 8 + wv];
        if (tot >= CAP) prefix = cand;
    }
    const unsigned T = prefix;
    int ngt = 0, neq = 0;
#pragma unroll
    for (int i = 0; i < 8; ++i) { ngt += (u[i] > T) ? 1 : 0; neq += (u[i] == T) ? 1 : 0; }
    int tot_gt = 0, tot_eq = 0;
    (void)block_excl_scan(F, ngt, red + 32, &tot_gt);
    int eqr = block_excl_scan(F, neq, red + 48, &tot_eq);
    const int need = CAP - tot_gt;
    bool sel[8]; int nsel = 0;
#pragma unroll
    for (int i = 0; i < 8; ++i) { bool sl = u[i] > T; if (u[i] == T) { sl = eqr < need; ++eqr; } sel[i] = sl; nsel += sl ? 1 : 0; }
    int tot_sel = 0;
    int slot = block_excl_scan(F, nsel, red + 64, &tot_sel);
    int* TOK = (int*)(F.ws + WS_TOK); float* VAL = (float*)(F.ws + WS_VAL); bf16_t* SLOT = (bf16_t*)(F.ws + WS_SLOT);
#pragma unroll
    for (int i = 0; i < 8; ++i) { const int sq = 8 * F.tid + i; unsigned short so = 0xFFFFu;
        if (sel[i]) { TOK[e * 4096 + b * CAP + slot] = b * SEQ + sq; VAL[e * 4096 + b * CAP + slot] = v[i]; so = (unsigned short)slot; ++slot; }
        SLOT[(size_t)(b * SEQ + sq) * 16 + e] = so; }
    __syncthreads();
}
__device__ __forceinline__ int wave_sum_i(int v) {
#pragma unroll
    for (int o = 1; o < 64; o <<= 1) v += __shfl_xor(v, o);
    return v;
}
__device__ __forceinline__ int wave_excl_scan_i(int x, int lane, int* tot) {
    int inc = x;
#pragma unroll
    for (int o = 1; o < 64; o <<= 1) { const int y = __shfl_up(inc, o); if (lane >= o) inc += y; }
    *tot = __shfl(inc, 63);
    return inc - x;
}
__device__ __forceinline__ void topk_wave(Frame& F, int b, int e) {
    const int lane = F.lane;
    const float* aff = (const float*)(F.ws + WS_AFF) + (size_t)(b * 16 + e) * SEQ + 64 * lane;
    unsigned u[64];
#pragma unroll
    for (int q = 0; q < 16; ++q) { const f32x4 v = *(const f32x4*)(aff + 4 * q); const float a0 = v.x, a1 = v.y, a2 = v.z, a3 = v.w;
        u[4 * q] = __float_as_uint(a0); u[4 * q + 1] = __float_as_uint(a1); u[4 * q + 2] = __float_as_uint(a2); u[4 * q + 3] = __float_as_uint(a3); }
    unsigned prefix = 0;
    for (int bit = 30; bit >= 0; --bit) { const unsigned cand = prefix | (1u << bit); int cnt = 0;
#pragma unroll
        for (int i = 0; i < 64; ++i) cnt += (int)((cand - 1u - u[i]) >> 31);
        if (wave_sum_i(cnt) >= CAP) prefix = cand; }
    const unsigned T = prefix; int ngt = 0, nge = 0;
#pragma unroll
    for (int i = 0; i < 64; ++i) { ngt += (int)((T - u[i]) >> 31); nge += (int)((T - 1u - u[i]) >> 31); }
    const int neq = nge - ngt;
    int tot_gt, tot_eq, tot_sel;
    (void)wave_excl_scan_i(ngt, lane, &tot_gt);
    int eqr = wave_excl_scan_i(neq, lane, &tot_eq);
    const int need = CAP - tot_gt;
    int nsel = 0; { int er = eqr;
#pragma unroll
        for (int i = 0; i < 64; ++i) { const int gt = (int)((T - u[i]) >> 31), eq = (int)((T - 1u - u[i]) >> 31) - gt;
            const int room = 1 ^ (int)((unsigned)(need - 1 - er) >> 31);
            nsel += gt | (eq & room); er += eq; } }
    int slot = wave_excl_scan_i(nsel, lane, &tot_sel);
    int* TOK = (int*)(F.ws + WS_TOK); float* VAL = (float*)(F.ws + WS_VAL); bf16_t* SLOT = (bf16_t*)(F.ws + WS_SLOT);
#pragma unroll
    for (int i = 0; i < 64; ++i) { const int sq = 64 * lane + i; const int gt = (int)((T - u[i]) >> 31), eq = (int)((T - 1u - u[i]) >> 31) - gt;
        const int room = 1 ^ (int)((unsigned)(need - 1 - eqr) >> 31); const int sl = gt | (eq & room); eqr += eq;
        if (sl) { TOK[e * 4096 + b * CAP + slot] = b * SEQ + sq; VAL[e * 4096 + b * CAP + slot] = __uint_as_float(u[i]); }
        SLOT[(size_t)(b * SEQ + sq) * 16 + e] = (bf16_t)(sl ? (unsigned)slot : 0xFFFFu); slot += sl;
        asm volatile("" ::: "memory"); }
}
#define FR_SW(s0, s1) {(unsigned)__builtin_amdgcn_readfirstlane((int)s0.x), (unsigned)__builtin_amdgcn_readfirstlane((int)s0.y), (unsigned)__builtin_amdgcn_readfirstlane((int)s0.z), (unsigned)__builtin_amdgcn_readfirstlane((int)s0.w), \
                       (unsigned)__builtin_amdgcn_readfirstlane((int)s1.x), (unsigned)__builtin_amdgcn_readfirstlane((int)s1.y), (unsigned)__builtin_amdgcn_readfirstlane((int)s1.z), (unsigned)__builtin_amdgcn_readfirstlane((int)s1.w)}
__device__ __forceinline__ int fr_issue(Frame& F, int m, u32x4 s0, u32x4 s1, u32x2 (&y0)[4], u32x2 (&y1)[4], u32x2 (&y2)[4], u32x2 (&y3)[4]) {
    const bf16_t* YE = (const bf16_t*)(F.ws + WS_WGU);
    const int b = m >> 12;
    const unsigned sw[8] = FR_SW(s0, s1);
    int k = 0, r0 = 0, r1 = 0, r2 = 0, r3 = 0;
#pragma unroll
    for (int e = 0; e < 16; ++e) { const unsigned sl = (sw[e >> 1] >> (16 * (e & 1))) & 0xffffu;
        if (sl != 0xFFFFu) { const int row = e * 4096 + b * CAP + (int)sl; r0 = k == 0 ? row : r0; r1 = k == 1 ? row : r1; r2 = k == 2 ? row : r2; r3 = k == 3 ? row : r3; ++k; } }
    if (k > 0) { const u32x2* yr = (const u32x2*)(YE + (size_t)r0 * DM) + F.lane;
#pragma unroll
        for (int j = 0; j < 4; ++j) y0[j] = yr[64 * j]; }
    if (k > 1) { const u32x2* yr = (const u32x2*)(YE + (size_t)r1 * DM) + F.lane;
#pragma unroll
        for (int j = 0; j < 4; ++j) y1[j] = yr[64 * j]; }
    if (k > 2) { const u32x2* yr = (const u32x2*)(YE + (size_t)r2 * DM) + F.lane;
#pragma unroll
        for (int j = 0; j < 4; ++j) y2[j] = yr[64 * j]; }
    if (k > 3) { const u32x2* yr = (const u32x2*)(YE + (size_t)r3 * DM) + F.lane;
#pragma unroll
        for (int j = 0; j < 4; ++j) y3[j] = yr[64 * j]; }
    return k;
}
#define FR_ACC(Y) do { _Pragma("unroll") for (int j = 0; j < 4; ++j) { v[j].x += bflo(Y[j].x); v[j].y += bfhi(Y[j].x); v[j].z += bflo(Y[j].y); v[j].w += bfhi(Y[j].y); } } while (0)
__device__ __forceinline__ void fr_accum(f32x4 (&v)[4], const u32x2 (&vin)[4], int k, const u32x2 (&y0)[4], const u32x2 (&y1)[4], const u32x2 (&y2)[4], const u32x2 (&y3)[4]) {
#pragma unroll
    for (int j = 0; j < 4; ++j) v[j] = bf4(vin[j]);
    if (k > 0) FR_ACC(y0);
    if (k > 1) FR_ACC(y1);
    if (k > 2) FR_ACC(y2);
    if (k > 3) FR_ACC(y3);
}
__device__ __forceinline__ void fr_finish(Frame& F, int m, const float (&gf)[16], float* outp, f32x4 (&v)[4], u32x4 s0, u32x4 s1, int k) {
    f32x4* orow = (f32x4*)(outp + (size_t)m * DM) + F.lane;
    if (k > 4) {
        const bf16_t* YE = (const bf16_t*)(F.ws + WS_WGU); const int b = m >> 12; const unsigned sw[8] = FR_SW(s0, s1);
        int kk = 0;
#pragma unroll
        for (int e = 0; e < 16; ++e) { const unsigned sl = (sw[e >> 1] >> (16 * (e & 1))) & 0xffffu;
            if (sl != 0xFFFFu) { if (kk >= 4) { const u32x2* yr = (const u32x2*)(YE + ((size_t)(e * 4096 + b * CAP + (int)sl)) * DM) + F.lane; u32x2 yy[4];
#pragma unroll
                    for (int j = 0; j < 4; ++j) yy[j] = yr[64 * j];
                    FR_ACC(yy); }
                ++kk; } }
    }
    float s = 0.f;
#pragma unroll
    for (int j = 0; j < 4; ++j) s += (v[j].x * v[j].x + v[j].y * v[j].y) + (v[j].z * v[j].z + v[j].w * v[j].w);
    s = wave_sum(s);
    const float rstd = 1.0f / sqrtf(s * (1.0f / DM) + EPS);
#pragma unroll
    for (int j = 0; j < 4; ++j) { f32x4 o; o.x = v[j].x * rstd * gf[4 * j]; o.y = v[j].y * rstd * gf[4 * j + 1]; o.z = v[j].z * rstd * gf[4 * j + 2]; o.w = v[j].w * rstd * gf[4 * j + 3]; orow[64 * j] = o; }
}
#undef FR_ACC
#undef FR_SW

struct Args { const float* in[28]; float* out; unsigned char* ws; int ph_lo, ph_hi; };
constexpr int NPHASE = 11;
__global__ void __launch_bounds__(NTHREADS, 2) mega_fwd(Args args) {
    extern __shared__ __attribute__((aligned(16))) unsigned char lds_raw[];
    Frame F;
    F.lds = (LAS unsigned char*)lds_raw;
    F.tid = threadIdx.x; F.lane = F.tid & 63; F.wave = __builtin_amdgcn_readfirstlane(F.tid >> 6);
    F.G = gridDim.x; { const int bx = blockIdx.x; F.vcu = (F.G % 8 == 0) ? (bx % 8) * (F.G / 8) + bx / 8 : bx; }
#pragma unroll
    for (int i = 0; i < 28; ++i) F.in[i] = args.in[i];
    F.out = args.out; F.ws = args.ws;
    volatile LAS unsigned* MISC = (volatile LAS unsigned*)(F.lds + LDS_MISC);
    if (F.tid < 64) MISC[F.tid] = 0u;
    __syncthreads();
    unsigned* ctl = (unsigned*)(F.ws + WS_CTL);
    XcdBarrier bar = xcd_barrier_post(ctl + 4096, MISC + 8);
    const int lo = args.ph_lo, hi = args.ph_hi;
#ifndef PHASE_MASK
#define PHASE_MASK 0x7ff
#endif
#define IN(k) (((PHASE_MASK >> (k)) & 1) && lo <= (k) && (k) < hi)
#define SEAM(k) do { if (IN(k) && IN((k) + 1)) { xcd_barrier(bar); if (REPS(14) > 1) xcd_barrier(bar); } } while (0)
    const int cblk = blockIdx.x;
    if (IN(0)) phase0(F);
    SEAM(0);
    if (IN(1)) { { ProbG1 p; p.K = DM; p.G = F.G; p.c = cblk; p.xb = (const char*)(F.ws + WS_XB); p.wint = (const char*)(F.ws + WS_WINT);
        p.ax = (bf16_t*)(F.ws + WS_AX); p.gg = (bf16_t*)(F.ws + WS_GG); p.gates = (bf16_t*)F.out; p.hyt = (bf16_t*)(F.ws + WS_HYT); p.rstd = (const float*)(F.ws + WS_RSTD1);
        pg8::gemm_phase(F.lds, p); } }
    SEAM(1);
    if (IN(2)) { for (int rp = 0; rp < REPS(11); ++rp) mixer_a_phase<1>(F);
        for (int rp = 0; rp < REPS(2); ++rp) { bf16_t* ob = (rp + 1 < REPS(2)) ? (bf16_t*)(F.ws + 460 * MiB) : (bf16_t*)(F.ws + WS_HYT);
            if (HYENA_FFT) hyena_phase_fft(F, ob); else hyena_phase(F, ob); } }
    SEAM(2);
    if (IN(3)) { for (int rp = 0; rp < REPS(3); ++rp) mixer_a_phase<2>(F);
        for (int rp = 0; rp < REPS(12); ++rp) ub_transpose_phase(F); }
    SEAM(3);
    if (IN(4)) { { ProbG4 p; p.K = DM; p.G = F.G; p.c = cblk; p.ua = (const char*)(F.ws + WS_XB); p.ub = (const char*)(F.ws + WS_HYT + 64 * MiB);
        p.wa = (const char*)(F.ws + WS_WA); p.wb = (const char*)(F.ws + WS_WB); p.gates = (const bf16_t*)F.out; p.merged = (bf16_t*)(F.ws + WS_AX);
        p.tmp = (f32x4*)(F.ws + WS_GG) + (size_t)cblk * (256 * 256 / 4);
        pg8::gemm_phase(F.lds, p); } }
    SEAM(4);
    if (IN(5)) { { ProbG5 p; p.K = DM; p.G = F.G; p.c = cblk; p.a = (const char*)(F.ws + WS_AX); p.b = (const char*)(F.ws + WS_WO); p.x = F.in[I_X]; p.xmid = (bf16_t*)(F.ws + WS_XMID);
        pg8::gemm_phase(F.lds, p); } }
    SEAM(5);
    if (IN(6)) { for (int rp = 0; rp < REPS(6); ++rp) phase6(F); }
    SEAM(6);
    if (IN(8)) { { ProbG8 p; p.K = DM / 2; p.G = F.G; p.c = cblk; p.h2 = (const char*)(F.ws + WS_H2); p.wgu = (const char*)(F.ws + WS_WGU); p.tok = (const int*)(F.ws + WS_TOK); p.act = F.ws + WS_ACT;
        pg8::gemm_phase(F.lds, p); } }
    SEAM(8);
    if (IN(9)) { { ProbG9 p; p.K = DFF / 2; p.G = F.G; p.c = cblk; p.act = (const char*)(F.ws + WS_ACT); p.wd = (const char*)(F.ws + WS_WD); p.val = (const float*)(F.ws + WS_VAL); p.ye = (bf16_t*)(F.ws + WS_WGU);
        pg8::gemm_phase(F.lds, p); } }
    SEAM(9);
    if (IN(10)) {
        float gf[16];
#pragma unroll
        for (int j = 0; j < 4; ++j) { const f32x4 g4 = *((const f32x4*)F.in[I_GFINAL] + 64 * j + F.lane); gf[4 * j] = g4.x; gf[4 * j + 1] = g4.y; gf[4 * j + 2] = g4.z; gf[4 * j + 3] = g4.w; }
#pragma unroll
    for (int j = 0; j < 16; ++j) asm volatile("" : "+v"(gf[j]));
        const int gw = F.vcu * NWAVES + F.wave, NGW = F.G * NWAVES;
        for (int rp = 0; rp < REPS(10); ++rp) { float* outp = (rp + 1 < REPS(10)) ? (float*)(F.ws + WS_ACT) : F.out;
            const bf16_t* SLOTB = (const bf16_t*)(F.ws + WS_SLOT); const bf16_t* XM = (const bf16_t*)(F.ws + WS_XMID);
            const u32x4 z4 = (u32x4){0u, 0u, 0u, 0u};
            u32x2 cur[4], nxt[4], nn[4]; u32x4 cs0 = z4, cs1 = z4, ns0 = z4, ns1 = z4, nns0, nns1; int ck = 0, nk;
            u32x2 cy0[4], cy1[4], cy2[4], cy3[4], ny0[4], ny1[4], ny2[4], ny3[4];
            if (gw < NT) { row_load_bf(XM, gw, F.lane, cur); cs0 = *(const u32x4*)(SLOTB + (size_t)gw * 16); cs1 = *(const u32x4*)(SLOTB + (size_t)gw * 16 + 8);
                ck = fr_issue(F, gw, cs0, cs1, cy0, cy1, cy2, cy3); }
#pragma unroll
            for (int j = 0; j < 4; ++j) nxt[j] = cur[j];
            if (gw + NGW < NT) { row_load_bf(XM, gw + NGW, F.lane, nxt); ns0 = *(const u32x4*)(SLOTB + (size_t)(gw + NGW) * 16); ns1 = *(const u32x4*)(SLOTB + (size_t)(gw + NGW) * 16 + 8); }
            for (int m = gw; m < NT; m += NGW) {
                f32x4 v[4];
                fr_accum(v, cur, ck, cy0, cy1, cy2, cy3);
                nk = 0;
                if (m + NGW < NT) nk = fr_issue(F, m + NGW, ns0, ns1, ny0, ny1, ny2, ny3);
#pragma unroll
                for (int j = 0; j < 4; ++j) nn[j] = nxt[j];
                nns0 = ns0; nns1 = ns1;
                if (m + 2 * NGW < NT) { row_load_bf(XM, m + 2 * NGW, F.lane, nn); nns0 = *(const u32x4*)(SLOTB + (size_t)(m + 2 * NGW) * 16); nns1 = *(const u32x4*)(SLOTB + (size_t)(m + 2 * NGW) * 16 + 8); }
                fr_finish(F, m, gf, outp, v, cs0, cs1, ck);
#pragma unroll
                for (int j = 0; j < 4; ++j) { cur[j] = nxt[j]; nxt[j] = nn[j]; cy0[j] = ny0[j]; cy1[j] = ny1[j]; cy2[j] = ny2[j]; cy3[j] = ny3[j]; }
                cs0 = ns0; cs1 = ns1; ns0 = nns0; ns1 = nns1; ck = nk; } }
    }
#undef IN
#undef SEAM
}

#ifndef MK_N_LAUNCHES
#define MK_N_LAUNCHES 1
#endif
extern "C" void kernel_launch(void* const* d_in, const int* in_sizes, int n_in, void* d_out, int out_size, void* d_ws, size_t ws_size, hipStream_t stream) {
    static int grid = 0;
    if (grid == 0) {
        if (n_in != 28 || out_size != NT * DM || ws_size < WS_END) { fprintf(stderr, "kernel_launch: unexpected shapes (n_in %d, out %d, ws %zu < %zu)\n", n_in, out_size, ws_size, (size_t)WS_END); grid = -1; return; }
        int dev = 0, cus = 0, per_cu = 0;
        (void)hipGetDevice(&dev); (void)hipDeviceGetAttribute(&cus, hipDeviceAttributeMultiprocessorCount, dev);
        if (hipFuncSetAttribute((const void*)mega_fwd, hipFuncAttributeMaxDynamicSharedMemorySize, LDS_BYTES) != hipSuccess) { fprintf(stderr, "kernel_launch: hipFuncSetAttribute failed\n"); grid = -1; return; }
        if (hipOccupancyMaxActiveBlocksPerMultiprocessor(&per_cu, (const void*)mega_fwd, NTHREADS, LDS_BYTES) != hipSuccess || per_cu < 1) { fprintf(stderr, "kernel_launch: occupancy query says %d\n", per_cu); per_cu = 1; }
        (void)hipGetLastError();
        grid = cus;
    }
    if (grid < 0) return;
    (void)hipMemsetAsync((char*)d_ws + WS_CTL, 0, CTL_BYTES, stream);
    Args a{};
    for (int i = 0; i < 28; ++i) a.in[i] = (const float*)d_in[i];
    a.out = (float*)d_out; a.ws = (unsigned char*)d_ws;
    if (MK_N_LAUNCHES == 1) {
        a.ph_lo = 0; a.ph_hi = NPHASE;
        void* kargs[] = {&a};
        hipError_t e = hipLaunchCooperativeKernel((const void*)mega_fwd, dim3(grid), dim3(NTHREADS), kargs, LDS_BYTES, stream);
        if (e != hipSuccess) fprintf(stderr, "cooperative launch failed: %s (grid %d)\n", hipGetErrorString(e), grid);
    } else {
        for (int p = 0; p < NPHASE; ++p) { a.ph_lo = p; a.ph_hi = p + 1; hipLaunchKernelGGL(mega_fwd, dim3(grid), dim3(NTHREADS), LDS_BYTES, stream, a); }
    }
}
```

```cpp
#include <hip/hip_runtime.h>
#include <cstdio>
#include <cstdint>

#ifndef EPI_REPS
#define EPI_REPS 1
#endif
#ifndef REPEAT_MASK
#define REPEAT_MASK 0
#endif
#define REPS(k) (1 + ((REPEAT_MASK >> (k)) & 1))
#define LAS __attribute__((address_space(3)))
#define GAS __attribute__((address_space(1)))
typedef unsigned short bf16_t;
typedef short bf16x8 __attribute__((ext_vector_type(8)));
typedef float f32x2 __attribute__((ext_vector_type(2)));
typedef int i32x4 __attribute__((ext_vector_type(4)));
typedef int i32x8 __attribute__((ext_vector_type(8)));
typedef float f32x4 __attribute__((ext_vector_type(4)));
typedef float f32x16 __attribute__((ext_vector_type(16)));
typedef unsigned u32x2 __attribute__((ext_vector_type(2)));
typedef unsigned u32x4 __attribute__((ext_vector_type(4)));

constexpr int NB = 8, SEQ = 4096, NT = NB * SEQ, DM = 1024, NEXP = 16, CAP = 512, DFF = 2048;
constexpr int INCOLS = 7168;
constexpr float EPS = 1e-6f;
constexpr int NWAVES = 8, NTHREADS = 512;

constexpr size_t MiB = 1u << 20;
constexpr size_t WS_CTL = 0, CTL_BYTES = 1 * MiB;
constexpr size_t WS_XB = 1 * MiB;
constexpr size_t WS_WINT = 65 * MiB;
constexpr size_t WS_WA = 79 * MiB, WS_WB = 81 * MiB, WS_WO = 83 * MiB;
constexpr size_t WS_FG = 85 * MiB;
constexpr size_t WS_AX = 117 * MiB;
constexpr size_t WS_GG = 181 * MiB;
constexpr size_t WS_HYT = 245 * MiB;
constexpr size_t WS_AGG = 437 * MiB;
constexpr size_t WS_GAGG = 453 * MiB;
constexpr size_t WS_RSTD1 = 455 * MiB;
constexpr size_t WS_H2 = 1 * MiB;
constexpr size_t WS_WD = 65 * MiB;
constexpr size_t WS_WGU = 129 * MiB;
constexpr size_t WS_ACT = 257 * MiB;
constexpr size_t WS_XMID = 385 * MiB;
constexpr size_t WS_AFF = 513 * MiB;
constexpr size_t WS_TOK = 515 * MiB;
constexpr size_t WS_VAL = 515 * MiB + 256 * 1024;
constexpr size_t WS_SLOT = 516 * MiB;
constexpr size_t WS_END = 520 * MiB;

constexpr int LDS_STAGE = 131072;
constexpr int LDS_MISC = 163840 - 1024;
constexpr int LDS_BYTES = 163840;

__device__ __forceinline__ unsigned f2bf(float f) { unsigned u = __builtin_bit_cast(unsigned, f); return (u + 0x7fffu + ((u >> 16) & 1u)) >> 16; }
__device__ __forceinline__ unsigned pk2(float lo, float hi) { return f2bf(lo) | (f2bf(hi) << 16); }
__device__ __forceinline__ float bf2f(unsigned b) { return __builtin_bit_cast(float, b << 16); }
__device__ __forceinline__ float bflo(unsigned w) { return __builtin_bit_cast(float, w << 16); }
__device__ __forceinline__ float bfhi(unsigned w) { return __builtin_bit_cast(float, w & 0xffff0000u); }
__device__ __forceinline__ unsigned cvt_pk_bf16(float lo, float hi) { unsigned r; asm volatile("v_cvt_pk_bf16_f32 %0, %1, %2" : "=v"(r) : "v"(lo), "v"(hi)); return r; }
__device__ __forceinline__ float wave_sum(float v) {
#pragma unroll
    for (int o = 1; o < 64; o <<= 1) v += __shfl_xor(v, o);
    return v;
}
__device__ __forceinline__ float fast_exp(float x) { return __builtin_amdgcn_exp2f(x * 1.44269504089f); }
__device__ __forceinline__ float fast_rcp(float x) { return __builtin_amdgcn_rcpf(x); }
__device__ __forceinline__ float sigmoidf_(float x) { return fast_rcp(1.0f + fast_exp(-x)); }
__device__ __forceinline__ float gelu_tanh(float x) {
    const float u = 1.5957691216f * (x + 0.044715f * x * x * x);
    return x * sigmoidf_(u);
}
#define LDS_WAIT() asm volatile("s_waitcnt lgkmcnt(0)" ::: "memory")
#define LDS_ORDER() asm volatile("" ::: "memory")
#define VM_WAIT() asm volatile("s_waitcnt vmcnt(0)" ::: "memory")

#define XB_TMO      128
#define XB_XCNT(j)  (256  + 64 * (j))
#define XB_XSUB(j)  (1280 + 64 * (j))
#define XB_XGEN(j)  (2304 + 64 * (j))
#define XB_TOP      3328
#define XB_TOPGEN   3392
#define XCD_BAR_WORDS 3456
#define XB_SPIN_CAP (1u << 20)
__device__ __forceinline__ unsigned xb_ld(unsigned* p)              { return __hip_atomic_load(p, __ATOMIC_RELAXED, __HIP_MEMORY_SCOPE_AGENT); }
__device__ __forceinline__ unsigned xb_add(unsigned* p, unsigned v) { return __hip_atomic_fetch_add(p, v, __ATOMIC_RELAXED, __HIP_MEMORY_SCOPE_AGENT); }
__device__ __forceinline__ unsigned xb_xcc_id() { return (unsigned)__builtin_amdgcn_s_getreg((3 << 11) | 20) & 0xFu; }
#define XB_SPIN(cond, bar) do { unsigned _sp = 0; while (cond) { __builtin_amdgcn_s_sleep(1); \
    if ((++_sp & 255u) == 0u) { if (xb_ld(&(bar)[XB_TMO])) break; if (_sp > XB_SPIN_CAP) { atomicAdd(&(bar)[XB_TMO], 1u); break; } } } } while (0)
struct XcdBarrier { unsigned* bar; unsigned x; volatile LAS unsigned* st; };
__device__ __forceinline__ XcdBarrier xcd_barrier_post(unsigned* bar, volatile LAS unsigned* st) {
    XcdBarrier b; b.bar = bar; b.x = xb_xcc_id(); b.st = st;
    if (threadIdx.x == 0) (void)xb_add(&bar[XB_XCNT(b.x)], 1u);
    return b;
}
__device__ __forceinline__ void xcd_barrier_complete(unsigned* bar, unsigned x, unsigned& nloc, unsigned& nx, unsigned& xmask) {
    const unsigned G = gridDim.x * gridDim.y * gridDim.z;
    unsigned sum, cnt, mine, msk, sp = 0u;
    for (;;) {
        sum = 0u; cnt = 0u; mine = 0u; msk = 0u;
#pragma unroll
        for (unsigned j = 0; j < 16; ++j) { const unsigned c = xb_ld(&bar[XB_XCNT(j)]); sum += c; cnt += (c > 0u) ? 1u : 0u; msk |= (c > 0u) ? (1u << j) : 0u; mine = (j == x) ? c : mine; }
        if (sum == G) break;
        __builtin_amdgcn_s_sleep(1);
        if ((++sp & 255u) == 0u) { if (xb_ld(&bar[XB_TMO])) break; if (sp > XB_SPIN_CAP) { atomicAdd(&bar[XB_TMO], 1u); break; } }
    }
    nloc = mine > 0u ? mine : 1u; nx = cnt > 0u ? cnt : 1u; xmask = msk;
}
__device__ __forceinline__ void xcd_barrier(const XcdBarrier& b) {
    asm volatile("s_waitcnt vmcnt(0)" ::: "memory");
    __syncthreads();
    if (threadIdx.x == 0) {
        unsigned* bar = b.bar;
        __builtin_amdgcn_s_waitcnt(0);
        unsigned nloc = b.st[0], nx = b.st[1], xmask = b.st[2];
        if (nloc == 0u) { xcd_barrier_complete(bar, b.x, nloc, nx, xmask); b.st[0] = nloc; b.st[1] = nx; b.st[2] = xmask; }
        const unsigned old = xb_add(&bar[XB_XSUB(b.x)], 1u);
        const unsigned gen = old / nloc;
        if (old + 1u == (gen + 1u) * nloc) {
            __builtin_amdgcn_fence(__ATOMIC_RELEASE, "agent");
            asm volatile("s_waitcnt vmcnt(0)" ::: "memory");
            const unsigned og = xb_add(&bar[XB_TOP], 1u);
            const unsigned tg = og / nx;
            if (og + 1u == (tg + 1u) * nx) {
#pragma unroll
                for (unsigned j = 0; j < 16; ++j) if ((xmask >> j) & 1u) (void)xb_add(&bar[XB_XGEN(j)], 1u);
            }
            XB_SPIN(xb_ld(&bar[XB_XGEN(b.x)]) == gen, bar);
            __builtin_amdgcn_fence(__ATOMIC_ACQUIRE, "agent");
            asm volatile("s_waitcnt vmcnt(0)" ::: "memory");
        } else {
            XB_SPIN(xb_ld(&bar[XB_XGEN(b.x)]) == gen, bar);
            __builtin_amdgcn_fence(__ATOMIC_ACQUIRE, "agent");
            asm volatile("s_waitcnt vmcnt(0)" ::: "memory");
        }
    }
    __syncthreads();
}

namespace pg8 {
constexpr int BM = 256, BK = 64, HALF = 128, HTB = HALF * BK * 2, STAGE_BYTES = 8 * HTB, NXCD = 8, WGM = 8;
__device__ __forceinline__ int lds_byte(int r, int c) { const int st = (r >> 4) * 2 + (c >> 5), rr = r & 15, cc = c & 31, ob = rr * 64 + cc * 2; return st * 1024 + (ob ^ (((ob >> 9) & 1) << 5)); }
__device__ __forceinline__ void stage_rc(int b, int& R, int& C) { const int st = b / 1024, sb = b % 1024, swz = sb ^ (((sb >> 9) & 1) << 5); R = (st >> 1) * 16 + swz / 64; C = (st & 1) * 32 + (swz % 64) / 2; }
__device__ __forceinline__ int perm32(int rho) { const int n = rho >> 4, i = rho & 15; return 8 * (i >> 2) + 4 * n + (i & 3); }
struct Unit { int pm, pn, g; };
struct Pre { f32x4 a, b, c, d; };
__device__ __forceinline__ i32x8 cat8(bf16x8 a, bf16x8 b) { return __builtin_shufflevector(__builtin_bit_cast(i32x4, a), __builtin_bit_cast(i32x4, b), 0, 1, 2, 3, 4, 5, 6, 7); }
__device__ __forceinline__ void mfma_f8(f32x4& acc, i32x8 a, i32x8 b, int sc) {
    asm volatile("v_mfma_scale_f32_16x16x128_f8f6f4 %0, %1, %2, %0, %3, %3 op_sel_hi:[0,0,0]" : "+v"(acc) : "v"(a), "v"(b), "v"(sc)); }
__device__ __forceinline__ void mfma_bf(f32x4& acc, bf16x8 a, bf16x8 b) { asm volatile("v_mfma_f32_16x16x32_bf16 %0, %1, %2, %0" : "+v"(acc) : "v"(a), "v"(b)); }
__device__ __forceinline__ void mfma_bfz(f32x4& acc, bf16x8 a, bf16x8 b) { asm volatile("v_mfma_f32_16x16x32_bf16 %0, %1, %2, 0" : "=&v"(acc) : "v"(a), "v"(b)); }
__device__ __forceinline__ void mfma_f8z(f32x4& acc, i32x8 a, i32x8 b, int sc) {
    asm volatile("v_mfma_scale_f32_16x16x128_f8f6f4 %0, %1, %2, 0, %3, %3 op_sel_hi:[0,0,0]" : "=&v"(acc) : "v"(a), "v"(b), "v"(sc)); }
__device__ __forceinline__ void tile_of(int L, int nM, int nN, int& pm, int& pn) {
    const int nwg = nM * nN; int wgid;
    { const int q = nwg / NXCD, r = nwg % NXCD, xcd = L % NXCD, off = L / NXCD; wgid = (xcd < r ? xcd * (q + 1) : r * (q + 1) + (xcd - r) * q) + off; }
    const int nig = WGM * nN, gid = wgid / nig, fm = gid * WGM, gsz = (nM - fm) < WGM ? (nM - fm) : WGM;
    pm = fm + ((wgid % nig) % gsz); pn = (wgid % nig) / gsz;
}
template <class P>
__device__ __forceinline__ void gemm_phase(LAS unsigned char* lds, const P& pr) {
    constexpr bool GATHER = P::GATHER;
    const int tid = threadIdx.x, wid = __builtin_amdgcn_readfirstlane(tid >> 6), lane = tid & 63, wr = wid >> 2, wc = wid & 3, fr = lane & 15, fq = lane >> 4;
    const int K = pr.K, nt = K / BK;
    unsigned voffB[2]; unsigned vAc[2][2], vAn[2][2]; int RA[2], CA[2];
    constexpr int PG8_TOK = STAGE_BYTES;
#pragma unroll
    for (int i = 0; i < 2; ++i) { int R, C; stage_rc(tid * 16 + i * 8192, R, C); const int Rb = P::PERM ? ((R & ~31) + perm32(R & 31)) : R;
        RA[i] = R; CA[i] = C; vAc[0][i] = (unsigned)(R * K + C) * 2u; vAc[1][i] = vAc[0][i]; vAn[0][i] = vAc[0][i]; vAn[1][i] = vAc[0][i]; voffB[i] = (unsigned)(Rb * K + C) * 2u; }
    const size_t kstep = (size_t)(BK * 2);
    const size_t hstep = (size_t)HALF * K * 2;
    const unsigned ldsw = (unsigned)wid * 1024u;
    const int aoff = lds_byte(wr * 64 + fr, fq * 8), boff = lds_byte(wc * 32 + fr, fq * 8);
#define PG8_SA(b, h) (((b) * 2 + (h)) * HTB)
#define PG8_SB(b, h) ((4 + (b) * 2 + (h)) * HTB)
#define PG8_STAGE(bufoff, gbase, voff) do { _Pragma("unroll") for (int _i = 0; _i < 2; ++_i) \
        __builtin_amdgcn_global_load_lds((const unsigned*)((const char*)(gbase) + (voff)[_i]), (LAS unsigned*)(lds + (bufoff) + ldsw + _i * 8192), 16, 0, 0); } while (0)
#define PG8_STAGE_A(bufoff, gbase, hh, V) PG8_STAGE(bufoff, (gbase) + (GATHER ? (size_t)0 : (size_t)(hh) * hstep), (V)[GATHER ? (hh) : 0])
#define PG8_LDA(dst, b, h) do { _Pragma("unroll") for (int m = 0; m < 4; ++m) _Pragma("unroll") for (int k = 0; k < 2; ++k) dst[m][k] = *(const LAS bf16x8*)(lds + PG8_SA(b, h) + aoff + m * 2048 + k * 1024); } while (0)
#define PG8_LDB(dst, b, h) do { _Pragma("unroll") for (int n = 0; n < 2; ++n) _Pragma("unroll") for (int k = 0; k < 2; ++k) dst[n][k] = *(const LAS bf16x8*)(lds + PG8_SB(b, h) + boff + n * 2048 + k * 1024); } while (0)
#define PG8_MMA(Z, ai, bj, At, Bt) do { __builtin_amdgcn_s_setprio(1); \
        if constexpr (P::FP8) { _Pragma("unroll") for (int m = 0; m < 4; ++m) _Pragma("unroll") for (int n = 0; n < 2; ++n) { \
            if constexpr (Z) pg8::mfma_f8z(acc[ai][bj][m][n], pg8::cat8(Bt[n][0], Bt[n][1]), pg8::cat8(At[m][0], At[m][1]), sc8); \
            else pg8::mfma_f8(acc[ai][bj][m][n], pg8::cat8(Bt[n][0], Bt[n][1]), pg8::cat8(At[m][0], At[m][1]), sc8); } } \
        else { _Pragma("unroll") for (int k = 0; k < 2; ++k) _Pragma("unroll") for (int m = 0; m < 4; ++m) _Pragma("unroll") for (int n = 0; n < 2; ++n) { \
            if ((Z) && k == 0) pg8::mfma_bfz(acc[ai][bj][m][n], Bt[n][k], At[m][k]); else pg8::mfma_bf(acc[ai][bj][m][n], Bt[n][k], At[m][k]); } } \
        __builtin_amdgcn_s_setprio(0); } while (0)
#define PG8_WAIT_V(n) asm volatile("s_waitcnt vmcnt(" #n ")" ::: "memory")
#define PG8_WAIT_L(n) asm volatile("s_waitcnt lgkmcnt(" #n ")" ::: "memory")
#define PG8_BAR __builtin_amdgcn_s_barrier()
#define PG8_SCHED __builtin_amdgcn_sched_barrier(0)
    Unit cur, nxt; int ui = 0;
    if (!pr.next(0, cur)) return;
    int sc8 = 0x7f7f7f7f; asm volatile("" : "+v"(sc8));
    (void)sc8;
    f32x4 acc[2][2][4][2];
    bf16x8 At[4][2], B0[2][2], B1[2][2];
    const char* cA = pr.a_base(cur); const char* cB = pr.b_base(cur);
    if constexpr (GATHER) {
#pragma unroll
        for (int h = 0; h < 2; ++h)
#pragma unroll
            for (int i = 0; i < 2; ++i) vAc[h][i] = pr.gather_off(cur, RA[i] + 128 * h) + (unsigned)CA[i] * 2u;
    }
    PG8_STAGE(PG8_SB(0, 0), cB, voffB); PG8_STAGE_A(PG8_SA(0, 0), cA, 0, vAc); PG8_STAGE(PG8_SB(0, 1), cB + hstep, voffB); PG8_STAGE_A(PG8_SA(0, 1), cA, 1, vAc);
    if (wr == 1) PG8_BAR;
    PG8_WAIT_V(4); PG8_BAR;
    PG8_STAGE(PG8_SB(1, 0), cB + kstep, voffB); PG8_STAGE_A(PG8_SA(1, 0), cA + kstep, 0, vAc); PG8_STAGE(PG8_SB(1, 1), cB + hstep + kstep, voffB);
    PG8_WAIT_V(6); PG8_BAR;
    for (;;) {
        pg8::Pre pre;
        if constexpr (P::HAS_PRE) pr.pre_load(cur, wr, wc, fr, fq, pre);
        const bool has_next = pr.next(ui + 1, nxt);
        const char* nA = has_next ? pr.a_base(nxt) : cA; const char* nB = has_next ? pr.b_base(nxt) : cB;
        if constexpr (GATHER) {
            if (has_next && wid < 4) __builtin_amdgcn_global_load_lds((const unsigned*)(pr.gather_ptr(nxt) + wid * 64 + lane), (LAS unsigned*)(lds + PG8_TOK + wid * 256), 4, 0, 0);
        }
#define PG8_KBODY(Z) { \
            const bool last = (t == nt - 2); \
            const char* a1 = cA + (size_t)(t + 1) * kstep; \
            const char* a2 = last ? nA : cA + (size_t)(t + 2) * kstep; const char* b2 = last ? nB : cB + (size_t)(t + 2) * kstep; \
            const char* a3 = a2 + kstep; const char* b3 = b2 + kstep; \
            unsigned vA2[2][2]; \
            if constexpr (GATHER) { \
                if (last && has_next) { \
_Pragma("unroll") \
                    for (int h = 0; h < 2; ++h) \
_Pragma("unroll") \
                        for (int i = 0; i < 2; ++i) vAn[h][i] = pr.gather_fin(*(volatile LAS int*)(lds + PG8_TOK + (RA[i] + 128 * h) * 4)) + (unsigned)CA[i] * 2u; \
                } \
_Pragma("unroll") \
                for (int h = 0; h < 2; ++h) \
_Pragma("unroll") \
                    for (int i = 0; i < 2; ++i) vA2[h][i] = (last && has_next) ? vAn[h][i] : vAc[h][i]; \
            } else { \
_Pragma("unroll") \
                for (int h = 0; h < 2; ++h) \
_Pragma("unroll") \
                    for (int i = 0; i < 2; ++i) vA2[h][i] = vAc[0][i]; \
            } \
            PG8_LDB(B0, 0, 0); PG8_SCHED; PG8_LDA(At, 0, 0); PG8_STAGE_A(PG8_SA(1, 1), a1, 1, vAc); \
            PG8_WAIT_L(8); PG8_BAR; PG8_WAIT_L(0); PG8_MMA(Z, 0, 0, At, B0); PG8_BAR; PG8_SCHED; \
            PG8_LDB(B1, 0, 1); PG8_STAGE(PG8_SB(0, 0), b2, voffB); \
            PG8_BAR; PG8_WAIT_L(0); PG8_MMA(Z, 0, 1, At, B1); PG8_BAR; \
            PG8_LDA(At, 0, 1); PG8_STAGE_A(PG8_SA(0, 0), a2, 0, vA2); \
            PG8_BAR; PG8_WAIT_L(0); PG8_MMA(Z, 1, 0, At, B0); PG8_BAR; PG8_SCHED; \
            PG8_STAGE(PG8_SB(0, 1), b2 + hstep, voffB); \
            PG8_WAIT_V(6); PG8_BAR; PG8_MMA(Z, 1, 1, At, B1); PG8_BAR; \
            PG8_LDB(B0, 1, 0); PG8_SCHED; PG8_LDA(At, 1, 0); PG8_STAGE_A(PG8_SA(0, 1), a2, 1, vA2); \
            PG8_WAIT_L(8); PG8_BAR; PG8_WAIT_L(0); PG8_MMA(false, 0, 0, At, B0); PG8_BAR; PG8_SCHED; \
            PG8_LDB(B1, 1, 1); PG8_STAGE(PG8_SB(1, 0), b3, voffB); \
            PG8_BAR; PG8_WAIT_L(0); PG8_MMA(false, 0, 1, At, B1); PG8_BAR; \
            PG8_LDA(At, 1, 1); PG8_STAGE_A(PG8_SA(1, 0), a3, 0, vA2); \
            PG8_BAR; PG8_WAIT_L(0); PG8_MMA(false, 1, 0, At, B0); PG8_BAR; PG8_SCHED; \
            PG8_STAGE(PG8_SB(1, 1), b3 + hstep, voffB); \
            PG8_WAIT_V(6); PG8_BAR; PG8_MMA(false, 1, 1, At, B1); PG8_BAR; \
        }
        { constexpr int t = 0; PG8_KBODY(true) }
        for (int t = 2; t < nt; t += 2) PG8_KBODY(false)
#undef PG8_KBODY
        {
            asm volatile("s_nop 15\n\ts_nop 15" ::: "memory");
#pragma unroll
            for (int a = 0; a < 2; ++a)
#pragma unroll
                for (int b = 0; b < 2; ++b)
#pragma unroll
                    for (int m = 0; m < 4; ++m)
#pragma unroll
                        for (int n = 0; n < 2; ++n) asm volatile("" : "+v"(acc[a][b][m][n]));
        }
        pr.epi(acc, cur, wr, wc, fr, fq, pre);
#if EPI_REPS > 1
        if constexpr (P::EPI2) { for (int er = 1; er < EPI_REPS; ++er) { asm volatile("" ::: "memory"); pr.epi(acc, cur, wr, wc, fr, fq, pre); } }
#endif
        if (!has_next) break;
        cur = nxt; cA = nA; cB = nB; ++ui;
        if constexpr (GATHER) {
#pragma unroll
            for (int h = 0; h < 2; ++h)
#pragma unroll
                for (int i = 0; i < 2; ++i) vAc[h][i] = vAn[h][i];
        }
    }
    PG8_WAIT_V(0);
    if (wr == 0) PG8_BAR;
    PG8_BAR;
#undef PG8_SA
#undef PG8_SB
#undef PG8_STAGE
#undef PG8_STAGE_A
#undef PG8_LDA
#undef PG8_LDB
#undef PG8_MMA
#undef PG8_WAIT_V
#undef PG8_WAIT_L
#undef PG8_BAR
#undef PG8_SCHED
}
}

struct Frame {
    LAS unsigned char* lds;
    int tid, lane, wave, vcu, G;
    const float* in[28]; float* out; unsigned char* ws;
};
enum { I_X = 0, I_GMIX, I_WIN, I_CAW, I_CAB, I_LWR, I_LBR, I_LWI, I_LBI, I_LAM, I_WAOUT, I_CBW, I_CBB, I_FW1, I_FB1, I_FW2, I_FB2, I_FW3, I_FFREQ, I_FBIAS, I_WBOUT, I_WO, I_GFFN, I_WROUTER, I_WGATE, I_WUP, I_WDOWN, I_GFINAL };

constexpr float W8_SCALE = 64.0f, W8_INV = 1.0f / 64.0f;
__device__ __forceinline__ float fp8_clamp(float x) { return __builtin_amdgcn_fmed3f(x, -448.0f, 448.0f); }
__device__ __forceinline__ unsigned pk4_fp8(float a, float b, float c, float d) { int w = 0; w = __builtin_amdgcn_cvt_pk_fp8_f32(a, b, w, false); w = __builtin_amdgcn_cvt_pk_fp8_f32(c, d, w, true); return (unsigned)w; }
struct F8Item { const float* W; unsigned char* WT; int K, N, mode, off, item; };
__device__ __forceinline__ void f8_issue(const F8Item& q, int lane, f32x4 (&v)[16]) {
    const int nblk = q.N / 64, kb = q.item / nblk, nb = q.item % nblk, k0 = 64 * kb, n0 = 64 * nb;
    const int r4 = lane >> 4, c4 = (lane & 15) * 4;
#pragma unroll
    for (int i = 0; i < 16; ++i) v[i] = *(const f32x4*)(q.W + (size_t)(k0 + 16 * r4 + i) * q.N + n0 + c4);
}
__device__ __forceinline__ void f8_finish(const F8Item& q, int lane, const f32x4 (&v)[16]) {
    const int nblk = q.N / 64, kb = q.item / nblk, nb = q.item % nblk, k0 = 64 * kb, n0 = 64 * nb;
    const int r4 = lane >> 4, c4 = (lane & 15) * 4;
#pragma unroll
    for (int j = 0; j < 4; ++j) { u32x4 o;
#pragma unroll
        for (int qd = 0; qd < 4; ++qd) o[qd] = pk4_fp8(v[4 * qd][j] * W8_SCALE, v[4 * qd + 1][j] * W8_SCALE, v[4 * qd + 2][j] * W8_SCALE, v[4 * qd + 3][j] * W8_SCALE);
        const int nn = n0 + c4 + j; const int row = (q.mode ? (256 * (nn >> 7) + (nn & 127)) : nn) + q.off;
        *(u32x4*)(q.WT + (size_t)row * q.K + k0 + 16 * r4) = o; }
}
__device__ __forceinline__ void transpose_item(const float* W, int K, int N, bf16_t* WT, const float* scale, int mode, int off, LAS unsigned char* scr, int item, int lane) {
    const int nblk = N / 64, kb = item / nblk, nb = item % nblk, k0 = 64 * kb, n0 = 64 * nb;
    const int r4 = lane >> 4, c4 = (lane & 15) * 4;
    f32x4 v[16];
#pragma unroll
    for (int i = 0; i < 16; ++i) v[i] = *(const f32x4*)(W + (size_t)(k0 + 4 * i + r4) * N + n0 + c4);
    float sc[16];
    if (scale) {
#pragma unroll
        for (int i = 0; i < 16; ++i) sc[i] = scale[k0 + 4 * i + r4]; }
#pragma unroll
    for (int i = 0; i < 16; ++i) { const int kk = 4 * i + r4; f32x4 x = v[i]; if (scale) x = x * sc[i];
        LAS unsigned* d = (LAS unsigned*)(scr + kk * 132 + c4 * 2); d[0] = pk2(x.x, x.y); d[1] = pk2(x.z, x.w); }
    LDS_WAIT();
    const int c = lane & 7;
#pragma unroll
    for (int j = 0; j < 8; ++j) { const int n = 8 * j + (lane >> 3); const LAS bf16_t* sp = (const LAS bf16_t*)(scr + (8 * c) * 132 + n * 2);
        u32x4 o; o.x = (unsigned)sp[0] | ((unsigned)sp[66] << 16); o.y = (unsigned)sp[132] | ((unsigned)sp[198] << 16); o.z = (unsigned)sp[264] | ((unsigned)sp[330] << 16); o.w = (unsigned)sp[396] | ((unsigned)sp[462] << 16);
        const int nn = n0 + n; const int row = (mode ? (256 * (nn >> 7) + (nn & 127)) : nn) + off;
        *(u32x4*)(WT + (size_t)row * K + k0 + 8 * c) = o; }
    LDS_WAIT();
}
__device__ __forceinline__ void row_load(const float* base, int m, int lane, f32x4 (&v)[4]) {
    const f32x4* xr = (const f32x4*)(base + (size_t)m * DM) + lane;
#pragma unroll
    for (int j = 0; j < 4; ++j) v[j] = xr[64 * j];
}
__device__ __forceinline__ void row_load_bf(const bf16_t* base, int m, int lane, u32x2 (&v)[4]) {
    const u32x2* xr = (const u32x2*)(base + (size_t)m * DM) + lane;
#pragma unroll
    for (int j = 0; j < 4; ++j) v[j] = xr[64 * j];
}
__device__ __forceinline__ f32x4 bf4(u32x2 w) { return (f32x4){bflo(w.x), bfhi(w.x), bflo(w.y), bfhi(w.y)}; }
__device__ __forceinline__ void p0_row(Frame& F, int m, const f32x4 (&v)[4]) {
    float s = 0.f;
#pragma unroll
    for (int j = 0; j < 4; ++j) s += (v[j].x * v[j].x + v[j].y * v[j].y) + (v[j].z * v[j].z + v[j].w * v[j].w);
    s = wave_sum(s);
    const float rstd = 1.0f / sqrtf(s * (1.0f / DM) + EPS);
    unsigned long long* o8 = (unsigned long long*)((bf16_t*)(F.ws + WS_XB) + (size_t)m * DM) + F.lane;
#pragma unroll
    for (int j = 0; j < 4; ++j) o8[64 * j] = (unsigned long long)pk2(v[j].x, v[j].y) | ((unsigned long long)pk2(v[j].z, v[j].w) << 32);
    if (F.lane == 0) ((float*)(F.ws + WS_RSTD1))[m] = rstd;
}
__device__ __forceinline__ void p0_filter_item(Frame& F, int tb) {
    LAS float* zb = (LAS float*)(F.lds); LAS float* h1 = (LAS float*)(F.lds + 4096); LAS float* h2T = (LAS float*)(F.lds + 8192);
    const float* w1 = F.in[I_FW1]; const float* b1 = F.in[I_FB1]; const float* w2 = F.in[I_FW2]; const float* b2 = F.in[I_FB2];
    const float* w3 = F.in[I_FW3]; const float* freq = F.in[I_FFREQ]; const float* fbias = F.in[I_FBIAS];
    const int t0 = tb * 16;
    for (int idx = F.tid; idx < 16 * 33; idx += NTHREADS) { const int tt = idx / 33, i = idx % 33, t = t0 + tt; float val;
        if (i == 0) val = (float)t * (1.0f / 4095.0f);
        else { const int k = (i - 1) & 15; const float fk = 1e-4f + (float)k * ((15.0f - 1e-4f) / 15.0f); const float w = (6.283185307179586f / 4096.0f) * (float)t; const float ang = w * fk;
            val = (i <= 16) ? cosf(ang) : -sinf(ang); }
        zb[tt * 36 + i] = val; }
    __syncthreads();
    for (int idx = F.tid; idx < 1024; idx += NTHREADS) { const int tt = idx >> 6, k = idx & 63; float s = b1[k];
        for (int i = 0; i < 33; ++i) s += zb[tt * 36 + i] * w1[i * 64 + k];
        h1[tt * 64 + k] = sinf(freq[k] * s); }
    __syncthreads();
    for (int idx = F.tid; idx < 1024; idx += NTHREADS) { const int tt = idx >> 6, k = idx & 63; float s = b2[k];
        for (int j = 0; j < 64; ++j) s += h1[tt * 64 + j] * w2[j * 64 + k];
        h2T[k * 16 + tt] = sinf(freq[64 + k] * s); }
    __syncthreads();
    const float min_decay = -3.0701134573f, max_decay = -15.3505672865f;
    bf16_t* FG = (bf16_t*)(F.ws + WS_FG);
    const int g = F.lane >> 4, j16 = F.lane & 15;
    float afr[16];
#pragma unroll
    for (int st = 0; st < 16; ++st) afr[st] = h2T[(4 * st + g) * 16 + j16];
#pragma unroll 1
    for (int blk = 0; blk < 8; ++blk) {
        const int col0 = 512 * F.wave + 64 * blk + 4 * j16;
        f32x4 bw[16];
#pragma unroll
        for (int st = 0; st < 16; ++st) bw[st] = *(const f32x4*)(w3 + (size_t)(4 * st + g) * 4096 + col0);
        __builtin_amdgcn_sched_barrier(0);
        f32x4 acc[4];
#pragma unroll
        for (int q = 0; q < 4; ++q) acc[q] = (f32x4){0.f, 0.f, 0.f, 0.f};
#pragma unroll
        for (int st = 0; st < 16; ++st)
#pragma unroll
            for (int q = 0; q < 4; ++q) acc[q] = __builtin_amdgcn_mfma_f32_16x16x4f32(afr[st], bw[st][q], acc[q], 0, 0, 0);
#pragma unroll
        for (int q = 0; q < 4; ++q) { const int col = col0 + q, n = col >> 11, dir = (col >> 10) & 1, c = col & 1023;
            const float dl = fabsf(min_decay + (float)c * ((max_decay - min_decay) / 1023.0f)) * -1.44269504089f;
            float o[4];
#pragma unroll
            for (int r = 0; r < 4; ++r) { const int t = t0 + 4 * g + r; o[r] = acc[q][r] * __builtin_amdgcn_exp2f((float)t * (1.0f / 4095.0f) * dl); }
            if (dir == 0 && t0 == 0 && g == 0) o[0] += fbias[n * 1024 + c];
            u32x2 w; w.x = cvt_pk_bf16(o[0], o[1]); w.y = cvt_pk_bf16(o[2], o[3]);
            *(u32x2*)(FG + ((size_t)((n * 2 + dir) * 1024 + c)) * 4096 + t0 + 4 * g) = w; }
    }
    __syncthreads();
}
__device__ __forceinline__ void p0_streaming(Frame& F) {
    LAS unsigned char* scr = F.lds + F.wave * 16384;
    const int gw = F.vcu * NWAVES + F.wave, NGW = F.G * NWAVES;
    constexpr int I_IN = (DM / 64) * (INCOLS / 64), I_SQ = (DM / 64) * (DM / 64);
    for (int it = gw; it < (I_IN + 3 * I_SQ) * REPS(0); it += NGW) {
        int r = REPS(0) > 1 ? it % (I_IN + 3 * I_SQ) : it;
        if (r < I_IN) { transpose_item(F.in[I_WIN], DM, INCOLS, (bf16_t*)(F.ws + WS_WINT), F.in[I_GMIX], 0, 0, scr, r, F.lane); continue; } r -= I_IN;
        if (r < I_SQ) { transpose_item(F.in[I_WAOUT], DM, DM, (bf16_t*)(F.ws + WS_WA), nullptr, 0, 0, scr, r, F.lane); continue; } r -= I_SQ;
        if (r < I_SQ) { transpose_item(F.in[I_WBOUT], DM, DM, (bf16_t*)(F.ws + WS_WB), nullptr, 0, 0, scr, r, F.lane); continue; } r -= I_SQ;
        transpose_item(F.in[I_WO], DM, DM, (bf16_t*)(F.ws + WS_WO), nullptr, 0, 0, scr, r, F.lane);
    }
    { f32x4 cur[4], nxt[4];
      if (gw < NT) row_load(F.in[I_X], gw, F.lane, cur);
      for (int m0 = gw; m0 < NT * REPS(0); m0 += NGW) { const int m = REPS(0) > 1 ? m0 % NT : m0, mn = REPS(0) > 1 ? (m0 + NGW) % NT : m0 + NGW;
#pragma unroll
          for (int j = 0; j < 4; ++j) nxt[j] = cur[j];
          if (m0 + NGW < NT * REPS(0)) row_load(F.in[I_X], mn, F.lane, nxt);
          p0_row(F, m, cur);
#pragma unroll
          for (int j = 0; j < 4; ++j) cur[j] = nxt[j]; } }
}
__device__ __forceinline__ void phase0(Frame& F) {
    if ((F.vcu & 1) == 0) { for (int tb = F.vcu; tb < 256 * REPS(15) * REPS(0); tb += F.G) p0_filter_item(F, tb & 255); __syncthreads(); p0_streaming(F); }
    else { p0_streaming(F); __syncthreads(); for (int tb = F.vcu; tb < 256 * REPS(15) * REPS(0); tb += F.G) p0_filter_item(F, tb & 255); }
}

using pg8::Unit;
typedef f32x4 Acc[2][2][4][2];
struct ProbG1 {
    static constexpr bool PERM = true, GATHER = false, FP8 = false, EPI2 = true, HAS_PRE = true; static constexpr int EPI_ST = 16;
    int K, G, c; const char* xb; const char* wint; bf16_t* ax; bf16_t* gg; bf16_t* gates; bf16_t* hyt; const float* rstd;
    __device__ __forceinline__ bool next(int i, Unit& u) const {
        int L = i * G + c; if (L >= (2048 + 1536) * REPS(1)) return false; if (REPS(1) > 1) L %= 2048 + 1536;
        if (L < 2048) { u.g = 0; pg8::tile_of(L, 128, 16, u.pm, u.pn); } else { u.g = 1; pg8::tile_of(L - 2048, 12, 128, u.pm, u.pn); }
        return true; }
    __device__ __forceinline__ const char* a_base(const Unit& u) const { return u.g == 0 ? xb + (size_t)u.pm * 256 * 2048 : wint + (size_t)(2048 + 256 * u.pm) * 2048; }
    __device__ __forceinline__ const char* b_base(const Unit& u) const { return u.g == 0 ? wint + (size_t)(u.pn < 8 ? 256 * u.pn : 256 * u.pn + 3072) * 2048 : xb + (size_t)u.pn * 256 * 2048; }
    __device__ __forceinline__ unsigned gather_off(const Unit&, int) const { return 0u; }
    __device__ __forceinline__ const int* gather_ptr(const Unit&) const { return nullptr; }
    __device__ __forceinline__ unsigned gather_fin(int) const { return 0u; }
    __device__ __forceinline__ void pre_load(const Unit& u, int wr, int wc, int fr, int fq, pg8::Pre& pre) const {
        if (u.g == 0) { const float* p = rstd + u.pm * 256 + wr * 64 + fr;
            pre.a = (f32x4){p[0], p[16], p[32], p[48]}; pre.b = (f32x4){p[128], p[144], p[160], p[176]}; pre.c = pre.a; pre.d = pre.b;
        } else { const float* p = rstd + u.pn * 256 + wc * 32 + 8 * fq;
            pre.a = *(const f32x4*)p; pre.b = *(const f32x4*)(p + 4); pre.c = *(const f32x4*)(p + 128); pre.d = *(const f32x4*)(p + 132); }
    }
    __device__ __forceinline__ void epi(const Acc& acc, const Unit& u, int wr, int wc, int fr, int fq, const pg8::Pre& pre) const {
        if (u.g == 0) {
            const int row0 = u.pm * 256 + wr * 64 + fr, cl = wc * 32 + 8 * fq;
#pragma unroll
            for (int ai = 0; ai < 2; ++ai)
#pragma unroll
                for (int m = 0; m < 4; ++m) { const int row = row0 + ai * 128 + m * 16; const float rs = ai == 0 ? pre.a[m] : pre.b[m];
#pragma unroll
                    for (int bj = 0; bj < 2; ++bj) { float o[8]; bf16_t* dst;
                        if (u.pn < 4) { dst = ax + (size_t)row * DM + u.pn * 256 + bj * 128 + cl;
#pragma unroll
                            for (int j = 0; j < 8; ++j) o[j] = acc[ai][bj][m][j >> 2][j & 3] * rs; }
                        else if (u.pn < 8) { dst = gg + (size_t)row * DM + (u.pn - 4) * 256 + bj * 128 + cl;
                            constexpr float k0 = -1.5957691216f * 1.44269504089f, k1 = k0 * 0.044715f;
#pragma unroll
                            for (int j = 0; j < 8; ++j) { const float x = acc[ai][bj][m][j >> 2][j & 3] * rs; const float w = __builtin_fmaf(x * x, k1, k0);
                                o[j] = x * fast_rcp(1.0f + __builtin_amdgcn_exp2f(x * w)); } }
                        else { dst = gates + (size_t)row * 2048 + (u.pn - 8) * 256 + bj * 128 + cl; const float rn = rs * -1.44269504089f;
#pragma unroll
                            for (int j = 0; j < 8; ++j) o[j] = fast_rcp(1.0f + __builtin_amdgcn_exp2f(acc[ai][bj][m][j >> 2][j & 3] * rn)); }
                        u32x4 w; w.x = cvt_pk_bf16(o[0], o[1]); w.y = cvt_pk_bf16(o[2], o[3]); w.z = cvt_pk_bf16(o[4], o[5]); w.w = cvt_pk_bf16(o[6], o[7]);
                        *(u32x4*)dst = w; } }
        } else {
            const int ch0 = u.pm * 256 + wr * 64 + fr, tl = u.pn * 256 + wc * 32 + 8 * fq;
            const f32x4 rs[2][2] = {{pre.a, pre.b}, {pre.c, pre.d}};
#pragma unroll
            for (int ai = 0; ai < 2; ++ai)
#pragma unroll
                for (int m = 0; m < 4; ++m) { const int ch = ch0 + ai * 128 + m * 16; const int part = ch >> 10, cc = ch & 1023;
#pragma unroll
                    for (int bj = 0; bj < 2; ++bj) { const int tok = tl + bj * 128; const int b = tok >> 12, s = tok & 4095;
                        const f32x4 v0 = acc[ai][bj][m][0] * rs[bj][0], v1 = acc[ai][bj][m][1] * rs[bj][1];
                        u32x4 w; w.x = cvt_pk_bf16(v0[0], v0[1]); w.y = cvt_pk_bf16(v0[2], v0[3]); w.z = cvt_pk_bf16(v1[0], v1[1]); w.w = cvt_pk_bf16(v1[2], v1[3]);
                        *(u32x4*)(hyt + ((size_t)((part * NB + b) * DM + cc)) * SEQ + s) = w; } }
        }
    }
};
struct ProbG4 {
    static constexpr bool PERM = true, GATHER = false, FP8 = false, EPI2 = false, HAS_PRE = false; static constexpr int EPI_ST = 16;
    int K, G, c; const char* ua; const char* ub; const char* wa; const char* wb; const bf16_t* gates; bf16_t* merged; f32x4* tmp;
    __device__ __forceinline__ bool next(int i, Unit& u) const { int L = (i >> 1) * G + c; if (L >= 512 * REPS(4)) return false; if (REPS(4) > 1) L %= 512; u.g = i & 1; pg8::tile_of(L, 128, 4, u.pm, u.pn); return true; }
    __device__ __forceinline__ const char* a_base(const Unit& u) const { return (u.g == 0 ? ua : ub) + (size_t)u.pm * 256 * 2048; }
    __device__ __forceinline__ const char* b_base(const Unit& u) const { return (u.g == 0 ? wa : wb) + (size_t)u.pn * 256 * 2048; }
    __device__ __forceinline__ unsigned gather_off(const Unit&, int) const { return 0u; }
    __device__ __forceinline__ const int* gather_ptr(const Unit&) const { return nullptr; }
    __device__ __forceinline__ unsigned gather_fin(int) const { return 0u; }
    __device__ __forceinline__ void epi(const Acc& acc, const Unit& u, int wr, int wc, int fr, int fq, const pg8::Pre& pre) const {
        const int row0 = u.pm * 256 + wr * 64 + fr, col0 = u.pn * 256 + wc * 32 + 8 * fq;
        const int goff = u.g == 0 ? 0 : 1024;
#pragma unroll
        for (int ai = 0; ai < 2; ++ai) {
            u32x4 gv[4][2], pv[4][2];
#pragma unroll
            for (int m = 0; m < 4; ++m) { const int row = row0 + ai * 128 + m * 16;
#pragma unroll
                for (int bj = 0; bj < 2; ++bj) { const int col = col0 + bj * 128;
                    gv[m][bj] = *(const u32x4*)(gates + (size_t)row * 2048 + goff + col);
                    pv[m][bj] = (u32x4){0u, 0u, 0u, 0u};
                    if (u.g != 0) pv[m][bj] = *(const u32x4*)(merged + (size_t)row * DM + col); } }
#pragma unroll
            for (int m = 0; m < 4; ++m) { const int row = row0 + ai * 128 + m * 16;
#pragma unroll
                for (int bj = 0; bj < 2; ++bj) { const int col = col0 + bj * 128; const u32x4 g4 = gv[m][bj], p4 = pv[m][bj];
                    const f32x4 a0 = acc[ai][bj][m][0], a1 = acc[ai][bj][m][1];
                    u32x4 w;
                    w.x = cvt_pk_bf16(bflo(g4.x) * a0[0] + bflo(p4.x), bfhi(g4.x) * a0[1] + bfhi(p4.x));
                    w.y = cvt_pk_bf16(bflo(g4.y) * a0[2] + bflo(p4.y), bfhi(g4.y) * a0[3] + bfhi(p4.y));
                    w.z = cvt_pk_bf16(bflo(g4.z) * a1[0] + bflo(p4.z), bfhi(g4.z) * a1[1] + bfhi(p4.z));
                    w.w = cvt_pk_bf16(bflo(g4.w) * a1[2] + bflo(p4.w), bfhi(g4.w) * a1[3] + bfhi(p4.w));
                    *(u32x4*)(merged + (size_t)row * DM + col) = w; } }
            asm volatile("" ::: "memory");
        }
    }
};
struct ProbG5 {
    static constexpr bool PERM = true, GATHER = false, FP8 = false, EPI2 = true, HAS_PRE = false; static constexpr int EPI_ST = 16;
    int K, G, c; const char* a; const char* b; const float* x; bf16_t* xmid;
    __device__ __forceinline__ bool next(int i, Unit& u) const { int L = i * G + c; if (L >= 512 * REPS(5)) return false; if (REPS(5) > 1) L %= 512; u.g = 0; pg8::tile_of(L, 128, 4, u.pm, u.pn); return true; }
    __device__ __forceinline__ const char* a_base(const Unit& u) const { return a + (size_t)u.pm * 256 * 2048; }
    __device__ __forceinline__ const char* b_base(const Unit& u) const { return b + (size_t)u.pn * 256 * 2048; }
    __device__ __forceinline__ unsigned gather_off(const Unit&, int) const { return 0u; }
    __device__ __forceinline__ const int* gather_ptr(const Unit&) const { return nullptr; }
    __device__ __forceinline__ unsigned gather_fin(int) const { return 0u; }
    __device__ __forceinline__ void epi(const Acc& acc, const Unit& u, int wr, int wc, int fr, int fq, const pg8::Pre&) const {
        const int row0 = u.pm * 256 + wr * 64 + fr, col0 = u.pn * 256 + wc * 32 + 8 * fq;
#pragma unroll
        for (int ai = 0; ai < 2; ++ai) {
            f32x4 xv[4][2][2];
#pragma unroll
            for (int m = 0; m < 4; ++m) { const size_t off = (size_t)(row0 + ai * 128 + m * 16) * DM + col0;
#pragma unroll
                for (int bj = 0; bj < 2; ++bj)
#pragma unroll
                    for (int n = 0; n < 2; ++n) xv[m][bj][n] = *(const f32x4*)(x + off + bj * 128 + n * 4); }
#pragma unroll
            for (int m = 0; m < 4; ++m) { const size_t off = (size_t)(row0 + ai * 128 + m * 16) * DM + col0;
#pragma unroll
                for (int bj = 0; bj < 2; ++bj) { const f32x4 v0 = xv[m][bj][0] + acc[ai][bj][m][0], v1 = xv[m][bj][1] + acc[ai][bj][m][1];
                    u32x4 w; w.x = cvt_pk_bf16(v0[0], v0[1]); w.y = cvt_pk_bf16(v0[2], v0[3]); w.z = cvt_pk_bf16(v1[0], v1[1]); w.w = cvt_pk_bf16(v1[2], v1[3]);
                    *(u32x4*)(xmid + off + bj * 128) = w; } }
            asm volatile("" ::: "memory");
        }
    }
};
struct ProbG8 {
    static constexpr bool PERM = true, GATHER = true, FP8 = true, EPI2 = true, HAS_PRE = false; static constexpr int EPI_ST = 8;
    int K, G, c; const char* h2; const char* wgu; const int* tok; unsigned char* act;
    __device__ __forceinline__ bool next(int i, Unit& u) const { int L = i * G + c; if (L >= 4096 * REPS(8)) return false; if (REPS(8) > 1) L %= 4096; u.g = L >> 8; pg8::tile_of(L & 255, 16, 16, u.pm, u.pn); return true; }
    __device__ __forceinline__ const char* a_base(const Unit&) const { return h2; }
    __device__ __forceinline__ const char* b_base(const Unit& u) const { return wgu + (size_t)(u.g * 4096 + 256 * u.pn) * 1024; }
    __device__ __forceinline__ unsigned gather_off(const Unit& u, int row) const { return (unsigned)tok[u.g * 4096 + 256 * u.pm + row] * 1024u; }
    __device__ __forceinline__ const int* gather_ptr(const Unit& u) const { return tok + u.g * 4096 + 256 * u.pm; }
    __device__ __forceinline__ unsigned gather_fin(int raw) const { return (unsigned)raw * 1024u; }
    __device__ __forceinline__ void epi(const Acc& acc, const Unit& u, int wr, int wc, int fr, int fq, const pg8::Pre& pre) const {
        const int row0 = u.pm * 256 + wr * 64 + fr, col0 = u.pn * 128 + wc * 32 + 8 * fq;
#pragma unroll
        for (int ai = 0; ai < 2; ++ai)
#pragma unroll
            for (int m = 0; m < 4; ++m) { const int row = row0 + ai * 128 + m * 16; float o[8];
#pragma unroll
                for (int n = 0; n < 2; ++n)
#pragma unroll
                    for (int j = 0; j < 4; ++j) { const float ag = acc[ai][0][m][n][j], au = acc[ai][1][m][n][j];
                        const float e = __builtin_amdgcn_exp2f(ag * (-1.44269504089f * W8_INV));
                        o[4 * n + j] = fp8_clamp((ag * au) * fast_rcp(__builtin_fmaf(e, 4096.0f, 4096.0f))); }
                u32x2 w; w.x = pk4_fp8(o[0], o[1], o[2], o[3]); w.y = pk4_fp8(o[4], o[5], o[6], o[7]);
                *(u32x2*)(act + ((size_t)(u.g * 4096 + row)) * DFF + col0) = w; }
    }
};
struct ProbG9 {
    static constexpr bool PERM = true, GATHER = false, FP8 = true, EPI2 = true, HAS_PRE = true; static constexpr int EPI_ST = 16;
    int K, G, c; const char* act; const char* wd; const float* val; bf16_t* ye;
    __device__ __forceinline__ bool next(int i, Unit& u) const { int L = i * G + c; if (L >= 1024 * REPS(9)) return false; if (REPS(9) > 1) L %= 1024; u.g = L >> 6; pg8::tile_of(L & 63, 16, 4, u.pm, u.pn); return true; }
    __device__ __forceinline__ const char* a_base(const Unit& u) const { return act + (size_t)(u.g * 4096 + 256 * u.pm) * 2048; }
    __device__ __forceinline__ const char* b_base(const Unit& u) const { return wd + (size_t)(u.g * 1024 + 256 * u.pn) * 2048; }
    __device__ __forceinline__ unsigned gather_off(const Unit&, int) const { return 0u; }
    __device__ __forceinline__ const int* gather_ptr(const Unit&) const { return nullptr; }
    __device__ __forceinline__ unsigned gather_fin(int) const { return 0u; }
    __device__ __forceinline__ void pre_load(const Unit& u, int wr, int, int fr, int, pg8::Pre& pre) const { const int row0 = u.pm * 256 + wr * 64 + fr;
        const float* p = val + u.g * 4096 + row0;
        pre.a = (f32x4){p[0], p[16], p[32], p[48]}; pre.b = (f32x4){p[128], p[144], p[160], p[176]}; pre.c = pre.a; pre.d = pre.b; }
    __device__ __forceinline__ void epi(const Acc& acc, const Unit& u, int wr, int wc, int fr, int fq, const pg8::Pre& pre) const {
        const int row0 = u.pm * 256 + wr * 64 + fr, col0 = u.pn * 256 + wc * 32 + 8 * fq;
#pragma unroll
        for (int ai = 0; ai < 2; ++ai)
#pragma unroll
            for (int m = 0; m < 4; ++m) { const int row = row0 + ai * 128 + m * 16; const float vs = (ai == 0 ? pre.a[m] : pre.b[m]) * W8_INV;
#pragma unroll
                for (int bj = 0; bj < 2; ++bj) { const f32x4 v0 = acc[ai][bj][m][0] * vs, v1 = acc[ai][bj][m][1] * vs;
                    u32x4 w; w.x = cvt_pk_bf16(v0[0], v0[1]); w.y = cvt_pk_bf16(v0[2], v0[3]); w.z = cvt_pk_bf16(v1[0], v1[1]); w.w = cvt_pk_bf16(v1[2], v1[3]);
                    *(u32x4*)(ye + ((size_t)(u.g * 4096 + row)) * DM + col0 + bj * 128) = w; } }
    }
};

constexpr int MA_WT_BYTES = 4 * 64 * 144, MA_SCR = 15744, MA_RAW = 11264, MA_XAT = 4608, MA_CB = 9216;
static_assert(MA_WT_BYTES + 8 * MA_SCR <= LDS_MISC, "mixer-A LDS");
__device__ __forceinline__ void mixer_a_load_w(Frame& F, int head) {
    LAS unsigned char* WT = F.lds;
    for (int idx = F.tid; idx < 4 * 4096; idx += NTHREADS) { const int mat = idx >> 12, i = (idx >> 6) & 63, j = idx & 63;
        const float* src = (mat & 1) ? F.in[I_LWI] : F.in[I_LWR]; const int dir = mat >> 1;
        const float v = src[(size_t)(dir * 16 + head) * 4096 + i * 64 + j];
        *(LAS bf16_t*)(WT + (mat * 64 + j) * 144 + i * 2) = (bf16_t)f2bf(v * -1.44269504089f); }
}
template <int PASS>
__device__ __forceinline__ void mixer_a_unit(Frame& F, int b, int head, int g) {
    LAS unsigned char* WT = F.lds; LAS unsigned char* scr = F.lds + MA_WT_BYTES + F.wave * MA_SCR;
    LAS unsigned char* raw = scr + MA_RAW; LAS unsigned char* xat = scr + MA_XAT; LAS float* cbuf = (LAS float*)(scr + MA_CB);
    const int lane = F.lane, col = lane & 31, h = lane >> 5;
    const bf16_t* AX = (const bf16_t*)(F.ws + WS_AX); const bf16_t* GG = (const bf16_t*)(F.ws + WS_GG); bf16_t* UA = (bf16_t*)(F.ws + WS_XB);
    f32x4* AGG = (f32x4*)(F.ws + WS_AGG); f32x4* GAGG = (f32x4*)(F.ws + WS_GAGG);
    float cw[2][4], cbias[2], br0[2], br1[2], bi0[2], bi1[2], sp0[2], sp1[2];
#pragma unroll
    for (int nt = 0; nt < 2; ++nt) { const int ch = head * 64 + 32 * nt + col;
#pragma unroll
        for (int k = 0; k < 4; ++k) cw[nt][k] = F.in[I_CAW][k * DM + ch];
        cbias[nt] = F.in[I_CAB][ch];
        br0[nt] = -1.44269504089f * F.in[I_LBR][ch]; br1[nt] = -1.44269504089f * F.in[I_LBR][DM + ch]; bi0[nt] = -1.44269504089f * F.in[I_LBI][ch]; bi1[nt] = -1.44269504089f * F.in[I_LBI][DM + ch];
        sp0[nt] = -8.0f * 1.44269504089f * log1pf(expf(-F.in[I_LAM][ch])); sp1[nt] = -8.0f * 1.44269504089f * log1pf(expf(-F.in[I_LAM][DM + ch])); }
    float cf[2] = {0.f, 0.f};
    float gPf[2] = {1.f, 1.f}, gHf[2] = {0.f, 0.f}, gPb[2] = {1.f, 1.f}, gHb[2] = {0.f, 0.f};
    if (PASS == 2) {
#pragma unroll
        for (int nt = 0; nt < 2; ++nt) { const int ch = head * 64 + 32 * nt + col;
            const f32x2* G2 = (const f32x2*)GAGG; const f32x2* A2 = (const f32x2*)AGG;
            int vb = b, vg = g; asm volatile("" : "+v"(vb), "+v"(vg));
            float c = 0.f;
            { f32x2 gf2[16];
#pragma unroll
              for (int gp = 0; gp < 16; ++gp) gf2[gp] = G2[((size_t)((vb * 16 + gp) * DM + ch)) * 2];
#pragma unroll
              for (int gp = 0; gp < 16; ++gp) { if (gp < g) c = gf2[gp].y + gf2[gp].x * c; } }
            cf[nt] = c;
            float cr = 0.f;
            { f32x2 gb2[16], cb2[8];
#pragma unroll
              for (int gp = 0; gp < 16; ++gp) gb2[gp] = G2[((size_t)((vb * 16 + gp) * DM + ch)) * 2 + 1];
#pragma unroll
              for (int k = 0; k < 8; ++k) cb2[k] = A2[((size_t)((vb * 128 + vg * 8 + k) * DM + ch)) * 2 + 1];
#pragma unroll
              for (int gp = 15; gp >= 0; --gp) { if (gp > g) cr = gb2[gp].y + gb2[gp].x * cr; }
#pragma unroll
              for (int k = 7; k >= 0; --k) { if (h == 0) cbuf[k * 64 + 32 * nt + col] = cr; cr = cb2[k].y + cb2[k].x * cr; } }
            asm volatile("" ::: "memory");
        }
        LDS_WAIT();
    }
    u32x4 pre[5];
#define MA_FETCH(tstart) do { _Pragma("unroll") for (int it = 0; it < 5; ++it) { const int rr = it * 8 + (lane >> 3), piece = lane & 7, s = (tstart) - 2 + rr; \
        pre[it] = (u32x4){0u, 0u, 0u, 0u}; \
        if (rr < 35 && s >= 0 && s < SEQ) pre[it] = *(const u32x4*)(AX + ((size_t)(b * SEQ + s)) * DM + head * 64 + piece * 8); } } while (0)
#define MA_COMMIT() do { _Pragma("unroll") for (int it = 0; it < 5; ++it) { const int rr = it * 8 + (lane >> 3), piece = lane & 7; \
        if (rr < 35) *(LAS u32x4*)(raw + rr * 128 + piece * 16) = pre[it]; } } while (0)
    MA_FETCH(g * 256);
    MA_COMMIT();
    MA_FETCH(g * 256 + 32);
    for (int k = 0; k < 8; ++k) {
        const int chunk = g * 8 + k, t0 = chunk * 32;
        LDS_WAIT();
        float xa[2][16];
#pragma unroll
        for (int nt = 0; nt < 2; ++nt)
#pragma unroll
            for (int q = 0; q < 4; ++q) { float rv[7];
#pragma unroll
                for (int e = 0; e < 7; ++e) rv[e] = bf2f(*(const LAS bf16_t*)(raw + (8 * q + 4 * h + e) * 128 + (32 * nt + col) * 2));
#pragma unroll
                for (int e = 0; e < 4; ++e) { const float v = cbias[nt] + cw[nt][0] * rv[e] + cw[nt][1] * rv[e + 1] + cw[nt][2] * rv[e + 2] + cw[nt][3] * rv[e + 3];
                    xa[nt][4 * q + e] = v; *(LAS bf16_t*)(xat + (8 * q + 4 * h + e) * 144 + (32 * nt + col) * 2) = (bf16_t)cvt_pk_bf16(v, v); } }
        LDS_WAIT();
        bf16x8 afr[4];
#pragma unroll
        for (int ks = 0; ks < 4; ++ks) afr[ks] = *(const LAS bf16x8*)(xat + col * 144 + (16 * ks + 8 * h) * 2);
        if (k < 7) { MA_COMMIT(); if (k < 6) MA_FETCH(t0 + 64); }
        if (PASS == 2 && lane < 32) __builtin_amdgcn_global_load_lds((const unsigned*)(GG + ((size_t)(b * SEQ + t0 + lane)) * DM + head * 64), (LAS unsigned*)(scr + 8192), 4, 0, 0);
        float hf[2][16];
#pragma unroll 1
        for (int d = 0; d < 2; ++d) {
#pragma unroll
            for (int nt = 0; nt < 2; ++nt) {
                const float brd = d ? br1[nt] : br0[nt], bid = d ? bi1[nt] : bi0[nt], spd = d ? sp1[nt] : sp0[nt];
                f32x16 ar, aiv;
#pragma unroll
                for (int i = 0; i < 16; ++i) { ar[i] = 0.f; aiv[i] = 0.f; }
#pragma unroll
                for (int ks = 0; ks < 4; ++ks) {
                    const bf16x8 bR = *(const LAS bf16x8*)(WT + ((2 * d + 0) * 64 + 32 * nt + col) * 144 + (16 * ks + 8 * h) * 2);
                    const bf16x8 bI = *(const LAS bf16x8*)(WT + ((2 * d + 1) * 64 + 32 * nt + col) * 144 + (16 * ks + 8 * h) * 2);
                    ar = __builtin_amdgcn_mfma_f32_32x32x16_bf16(afr[ks], bR, ar, 0, 0, 0);
                    aiv = __builtin_amdgcn_mfma_f32_32x32x16_bf16(afr[ks], bI, aiv, 0, 0, 0);
                }
                const float pre0 = aiv[0], pre15 = aiv[15];
#pragma unroll
                for (int i = 0; i < 16; ++i) {
                    const float r = fast_rcp(1.0f + __builtin_amdgcn_exp2f(ar[i] + brd)), ig = fast_rcp(1.0f + __builtin_amdgcn_exp2f(aiv[i] + bid));
                    const float a = __builtin_amdgcn_exp2f(r * spd);
                    const float mult = __builtin_amdgcn_sqrtf(__builtin_fmaf(-a, a, 1.0f));
                    ar[i] = a; aiv[i] = mult * ig * xa[nt][i]; }
                if (t0 == 0 || t0 == SEQ - 32) {
                    if (d == 0 && t0 == 0 && h == 0) aiv[0] = fast_rcp(1.0f + __builtin_amdgcn_exp2f(pre0 + bid)) * xa[nt][0];
                    if (d == 1 && t0 == SEQ - 32 && h == 1) aiv[15] = fast_rcp(1.0f + __builtin_amdgcn_exp2f(pre15 + bid)) * xa[nt][15]; }
            {
                float P[4], H[4], pP[4], pH[4];
#pragma unroll
                for (int q = 0; q < 4; ++q) { float p = 1.f, hh = 0.f;
                    if (d == 0) {
#pragma unroll
                        for (int e = 0; e < 4; ++e) { hh = ar[4 * q + e] * hh + aiv[4 * q + e]; p *= ar[4 * q + e]; }
                    } else {
#pragma unroll
                        for (int e = 3; e >= 0; --e) { hh = ar[4 * q + e] * hh + aiv[4 * q + e]; p *= ar[4 * q + e]; }
                    }
                    P[q] = p; H[q] = hh; pP[q] = __shfl_xor(p, 32); pH[q] = __shfl_xor(hh, 32); }
                float c = (PASS == 2) ? (d == 0 ? cf[nt] : cbuf[k * 64 + 32 * nt + col]) : 0.f;
                float ptot = 1.f, cin[4];
                if (d == 0) {
#pragma unroll
                    for (int q = 0; q < 4; ++q) { const float P1 = h ? pP[q] : P[q], H1 = h ? pH[q] : H[q], P2 = h ? P[q] : pP[q], H2 = h ? H[q] : pH[q];
                        const float c1 = H1 + P1 * c; cin[q] = h ? c1 : c; c = H2 + P2 * c1; ptot *= P1 * P2; }
                } else {
#pragma unroll
                    for (int q = 3; q >= 0; --q) { const float P1 = h ? P[q] : pP[q], H1 = h ? H[q] : pH[q], P2 = h ? pP[q] : P[q], H2 = h ? pH[q] : H[q];
                        const float c1 = H1 + P1 * c; cin[q] = h ? c : c1; c = H2 + P2 * c1; ptot *= P1 * P2; }
                }
                if (PASS == 1) {
                    if (d == 0) { gHf[nt] = c + ptot * gHf[nt]; gPf[nt] *= ptot; cf[nt] = ptot; hf[nt][0] = c; }
                    else { gHb[nt] += gPb[nt] * c; gPb[nt] *= ptot;
                        if (h == 0) AGG[(size_t)(b * 128 + chunk) * DM + head * 64 + 32 * nt + col] = (f32x4){cf[nt], hf[nt][0], ptot, c}; }
                } else {
                    if (d == 0) { cf[nt] = c;
#pragma unroll
                        for (int q = 0; q < 4; ++q) { float hh = cin[q];
#pragma unroll
                            for (int e = 0; e < 4; ++e) { hh = ar[4 * q + e] * hh + aiv[4 * q + e]; ((LAS float*)scr)[(8 * q + 4 * h + e) * 64 + 32 * nt + col] = hh; } }
                    } else {
#pragma unroll
                        for (int q = 0; q < 4; ++q) { float hh = cin[q];
#pragma unroll
                            for (int e = 3; e >= 0; --e) { hh = ar[4 * q + e] * hh + aiv[4 * q + e];
                                LAS float* ps = (LAS float*)scr + (8 * q + 4 * h + e) * 64 + 32 * nt + col; *ps = *ps + hh; } }
                    }
                }
            }
            }
        }
        if (PASS == 2) {
            LDS_WAIT();
            u32x4 gvv[4];
#pragma unroll
            for (int it = 0; it < 4; ++it) gvv[it] = *(const u32x4*)(GG + ((size_t)(b * SEQ + t0 + it * 8 + (lane >> 3))) * DM + head * 64 + (lane & 7) * 8);
#pragma unroll
            for (int it = 0; it < 4; ++it) { const int row = it * 8 + (lane >> 3), piece = lane & 7;
                const f32x4 s0 = *(const LAS f32x4*)(scr + (row * 64 + piece * 8) * 4), s1 = *(const LAS f32x4*)(scr + (row * 64 + piece * 8 + 4) * 4);
                const size_t o = ((size_t)(b * SEQ + t0 + row)) * DM + head * 64 + piece * 8;
                const u32x4 gv = gvv[it];
                u32x4 w; w.x = cvt_pk_bf16(s0.x * bflo(gv.x), s0.y * bfhi(gv.x)); w.y = cvt_pk_bf16(s0.z * bflo(gv.y), s0.w * bfhi(gv.y));
                w.z = cvt_pk_bf16(s1.x * bflo(gv.z), s1.y * bfhi(gv.z)); w.w = cvt_pk_bf16(s1.z * bflo(gv.w), s1.w * bfhi(gv.w));
                *(u32x4*)(UA + o) = w; }
            LDS_WAIT();
        }
    }
#undef MA_FETCH
#undef MA_COMMIT
    if (PASS == 1 && h == 0) {
#pragma unroll
        for (int nt = 0; nt < 2; ++nt) GAGG[(size_t)(b * 16 + g) * DM + head * 64 + 32 * nt + col] = (f32x4){gPf[nt], gHf[nt], gPb[nt], gHb[nt]};
    }
}
template <int PASS>
__device__ __forceinline__ void mixer_a_phase(Frame& F) {
    for (int blk = F.vcu; blk < 256; blk += F.G) {
        const int b = blk >> 5, head = (blk >> 1) & 15, gh = blk & 1;
        __syncthreads();
        mixer_a_load_w(F, head);
        LDS_WAIT(); __syncthreads();
        mixer_a_unit<PASS>(F, b, head, gh * 8 + F.wave);
    }
    __syncthreads();
}

constexpr int HY_PITCH = 10256, HY_PAD = 512, HY_U = 0, HY_C0 = 82176, HY_COPY = 16640, HY_C1 = HY_C0 + HY_COPY + 68, HY_OFFR = 4160, HY_NEL = 8320;
__device__ __forceinline__ int hy_uaddr(int b, int s) { const int e = s + HY_PAD, q = e >> 3; return b * HY_PITCH + ((q ^ (((q >> 4) & 3) << 2)) << 4) + ((e & 7) << 1); }
struct HyU { u32x4 mv[NB]; unsigned pvb[NB], nvb[NB]; };
struct HyF { u32x4 vf, vb; };
__device__ __forceinline__ void hy_fetch_u(Frame& F, int part, int c, HyU& r) {
    const bf16_t* HYT = (const bf16_t*)(F.ws + WS_HYT); const int s0 = 8 * F.tid;
#pragma unroll
    for (int b = 0; b < NB; ++b) { const bf16_t* src = HYT + ((size_t)((part * NB + b) * DM + c)) * SEQ;
        r.mv[b] = *(const u32x4*)(src + s0); r.pvb[b] = s0 > 0 ? (unsigned)src[s0 - 1] : 0u; r.nvb[b] = (s0 + 8 < SEQ) ? (unsigned)src[s0 + 8] : 0u; }
}
__device__ __forceinline__ void hy_commit_u(Frame& F, int part, int c, const HyU& r) {
    const float w0 = F.in[I_CBW][0 * 3072 + part * 1024 + c], w1 = F.in[I_CBW][1 * 3072 + part * 1024 + c], w2 = F.in[I_CBW][2 * 3072 + part * 1024 + c], bb = F.in[I_CBB][part * 1024 + c];
    const int s0 = 8 * F.tid;
#pragma unroll
    for (int b = 0; b < NB; ++b) {
        float x[10]; x[0] = bf2f(r.pvb[b]); x[1] = bflo(r.mv[b].x); x[2] = bfhi(r.mv[b].x); x[3] = bflo(r.mv[b].y); x[4] = bfhi(r.mv[b].y); x[5] = bflo(r.mv[b].z); x[6] = bfhi(r.mv[b].z); x[7] = bflo(r.mv[b].w); x[8] = bfhi(r.mv[b].w); x[9] = bf2f(r.nvb[b]);
        float o[8];
#pragma unroll
        for (int e = 0; e < 8; ++e) o[e] = bb + w0 * x[e] + w1 * x[e + 1] + w2 * x[e + 2];
        *(LAS u32x4*)(F.lds + HY_U + hy_uaddr(b, s0)) = (u32x4){pk2(o[0], o[1]), pk2(o[2], o[3]), pk2(o[4], o[5]), pk2(o[6], o[7])};
    }
}
__device__ __forceinline__ void hy_put(Frame& F, int i, unsigned v) {
    *(LAS bf16_t*)(F.lds + HY_C0 + 2 * (i + HY_OFFR)) = (bf16_t)v;
    *(LAS bf16_t*)(F.lds + HY_C1 + 2 * (i - 1 + HY_OFFR)) = (bf16_t)v;
}
__device__ __forceinline__ void hy_fetch_f(Frame& F, int order, int c, HyF& r) {
    const bf16_t* hf = (const bf16_t*)(F.ws + WS_FG) + ((size_t)((order * 2 + 0) * 1024 + c)) * 4096;
    const bf16_t* hb = (const bf16_t*)(F.ws + WS_FG) + ((size_t)((order * 2 + 1) * 1024 + c)) * 4096;
    r.vf = *(const u32x4*)(hf + 8 * F.tid); r.vb = *(const u32x4*)(hb + 8 * F.tid);
}
__device__ __forceinline__ void hy_commit_f(Frame& F, const HyF& r) {
    const int t0 = 8 * F.tid;
    const unsigned wf[4] = {r.vf.x, r.vf.y, r.vf.z, r.vf.w}, wb[4] = {r.vb.x, r.vb.y, r.vb.z, r.vb.w};
#pragma unroll
    for (int e = 0; e < 8; ++e) { const unsigned f = (wf[e >> 1] >> (16 * (e & 1))) & 0xffffu, bk = (wb[e >> 1] >> (16 * (e & 1))) & 0xffffu; const int t = t0 + e;
        hy_put(F, -t, f);
        if (t > 0) hy_put(F, t, bk); }
}
__device__ __forceinline__ void hy_zero_filter(Frame& F) {
    for (int i = F.tid; i < (HY_C1 + HY_COPY - HY_C0) / 4; i += NTHREADS) *(LAS unsigned*)(F.lds + HY_C0 + 4 * i) = 0u;
}
struct A4 { unsigned x, y, z, w; } __attribute__((aligned(4)));
__device__ __forceinline__ bf16x8 hy_lda(LAS unsigned char* p) { const LAS unsigned* q = (const LAS unsigned*)p; u32x4 v; v.x = q[0]; v.y = q[1]; v.z = q[2]; v.w = q[3]; return __builtin_bit_cast(bf16x8, v); }
__device__ __forceinline__ bf16x8 hy_ldb(LAS unsigned char* ub, int q) { return *(const LAS bf16x8*)(ub + ((q ^ (((q >> 4) & 3) << 2)) << 4)); }
__device__ __forceinline__ void hy_conv(Frame& F, f32x16 (&acc)[4]) {
    const int lane = F.lane, w = F.wave, r = lane & 31, h = lane >> 5, n = lane & 31, bq = n >> 2, ap = n & 3;
#pragma unroll
    for (int j = 0; j < 4; ++j)
#pragma unroll
        for (int i = 0; i < 16; ++i) acc[j][i] = 0.f;
    const int p = r & 1;
    LAS unsigned char* abase = F.lds + (p ? HY_C1 : HY_C0) + 2 * (8 * h - r - p + HY_OFFR) - 2 * (512 * w - 4080);
    LAS unsigned char* ub = F.lds + HY_U + bq * HY_PITCH;
    const int q0 = 16 * ap + 574 + h;
    bf16x8 Bw[2][4];
    Bw[0][3] = hy_ldb(ub, q0 + 4); Bw[0][2] = hy_ldb(ub, q0 + 8); Bw[0][1] = hy_ldb(ub, q0 + 12);
    Bw[1][3] = hy_ldb(ub, q0 + 2); Bw[1][2] = hy_ldb(ub, q0 + 6); Bw[1][1] = hy_ldb(ub, q0 + 10);
    Bw[0][0] = Bw[0][1]; Bw[1][0] = Bw[1][1];
    bf16x8 an = hy_lda(abase), bn = hy_ldb(ub, q0);
    for (int kk = 0; kk < 288; kk += 8) {
#pragma unroll
        for (int u = 0; u < 8; ++u) {
            const int k = kk + u, par = u & 1, slot = u >> 1;
            const bf16x8 a = an; Bw[par][slot] = bn;
            const int k1 = (k + 1 < 288) ? k + 1 : 287;
            an = hy_lda(abase - 32 * k1); bn = hy_ldb(ub, q0 - 2 * k1);
            __builtin_amdgcn_s_setprio(1);
#pragma unroll
            for (int j = 0; j < 4; ++j) acc[j] = __builtin_amdgcn_mfma_f32_32x32x16_bf16(a, Bw[par][(slot - j) & 3], acc[j], 0, 0, 0);
            __builtin_amdgcn_s_setprio(0);
        }
    }
}
__device__ __forceinline__ void hyena_channel(Frame& F, int c, int cnext, bf16_t* UBT, HyU& pu, HyF& pf) {
    const int lane = F.lane, w = F.wave, h = lane >> 5, n = lane & 31, bq = n >> 2, ap = n & 3;
    f32x16 acc[4];
    __syncthreads();
    hy_commit_u(F, 0, c, pu); hy_commit_f(F, pf);
    LDS_WAIT(); __syncthreads();
    hy_fetch_u(F, 1, c, pu); hy_fetch_f(F, 1, c, pf);
    hy_conv(F, acc);
    __syncthreads();
    hy_commit_u(F, 1, c, pu); hy_commit_f(F, pf);
    LDS_WAIT(); __syncthreads();
#pragma unroll
    for (int j = 0; j < 4; ++j)
#pragma unroll
        for (int qd = 0; qd < 4; ++qd) { const int t = 512 * w + 32 * j + 128 * ap + 8 * qd + 4 * h;
            LAS u32x2* pz = (LAS u32x2*)(F.lds + HY_U + hy_uaddr(bq, t)); const u32x2 xv = *pz;
            u32x2 o; o.x = pk2(bflo(xv.x) * acc[j][4 * qd + 0], bfhi(xv.x) * acc[j][4 * qd + 1]); o.y = pk2(bflo(xv.y) * acc[j][4 * qd + 2], bfhi(xv.y) * acc[j][4 * qd + 3]);
            *pz = o; }
    LDS_WAIT(); __syncthreads();
    hy_fetch_u(F, 2, c, pu);
    hy_conv(F, acc);
    __syncthreads();
    hy_commit_u(F, 2, c, pu);
    LDS_WAIT(); __syncthreads();
    if (cnext >= 0) { hy_fetch_u(F, 0, cnext, pu); hy_fetch_f(F, 0, cnext, pf); }
#pragma unroll
    for (int j = 0; j < 4; ++j)
#pragma unroll
        for (int qd = 0; qd < 4; ++qd) { const int t = 512 * w + 32 * j + 128 * ap + 8 * qd + 4 * h;
            const u32x2 xv = *(const LAS u32x2*)(F.lds + HY_U + hy_uaddr(bq, t));
            u32x2 o; o.x = pk2(bflo(xv.x) * acc[j][4 * qd + 0], bfhi(xv.x) * acc[j][4 * qd + 1]); o.y = pk2(bflo(xv.y) * acc[j][4 * qd + 2], bfhi(xv.y) * acc[j][4 * qd + 3]);
            *(u32x2*)(UBT + ((size_t)(bq * DM + c)) * SEQ + t) = o; }
}
__device__ __forceinline__ void hyena_phase(Frame& F, bf16_t* UBT) {
    __syncthreads();
    for (int i = F.tid; i < (NB * HY_PITCH) / 16; i += NTHREADS) *(LAS u32x4*)(F.lds + HY_U + i * 16) = (u32x4){0u, 0u, 0u, 0u};
    hy_zero_filter(F);
    LDS_WAIT(); __syncthreads();
    HyU pu; HyF pf;
    if (F.vcu < DM) { hy_fetch_u(F, 0, F.vcu, pu); hy_fetch_f(F, 0, F.vcu, pf); }
    for (int c = F.vcu; c < DM; c += F.G) hyena_channel(F, c, (c + F.G < DM) ? c + F.G : -1, UBT, pu, pf);
    __syncthreads();
}

constexpr int FU = 0, FW = 65536, FW2 = 98304, FPL = 16384;
#ifndef HYENA_FFT
#define HYENA_FFT 1
#endif
typedef f32x4 facc;
__device__ __forceinline__ facc fmma(bf16x8 a, bf16x8 b) { return __builtin_amdgcn_mfma_f32_16x16x32_bf16(a, b, (facc){0.f, 0.f, 0.f, 0.f}, 0, 0, 0); }
__device__ __forceinline__ facc fmma_acc(bf16x8 a, bf16x8 b, facc c) { return __builtin_amdgcn_mfma_f32_16x16x32_bf16(a, b, c, 0, 0, 0); }
__device__ __forceinline__ bf16x8 dft_frag(int R, float sgn, int joff, int kidx, int g, int part) {
    u32x4 w; unsigned* pw = (unsigned*)&w; const int half = g >> 1; const float rinv = 1.0f / (float)R;
#pragma unroll
    for (int e2 = 0; e2 < 4; ++e2) { float v[2];
#pragma unroll
        for (int q = 0; q < 2; ++q) { const int j = joff + 8 * (g & 1) + 2 * e2 + q; const float f = (float)((j * kidx) & (R - 1)) * rinv;
            const float c = __builtin_amdgcn_cosf(f), sn = sgn * __builtin_amdgcn_sinf(f);
            v[q] = part == 0 ? (half == 0 ? c : -sn) : (half == 0 ? sn : c); }
        pw[e2] = pk2(v[0], v[1]); }
    return __builtin_bit_cast(bf16x8, w);
}
__device__ __forceinline__ bf16x8 ld_frag(LAS unsigned char* base, int elem_off, int g) { return *(const LAS bf16x8*)(base + (g >> 1) * FPL + (elem_off + 8 * (g & 1)) * 2); }
__device__ __forceinline__ void st_quad(LAS unsigned char* base, int elem_off, const float (&re)[4], const float (&im)[4]) {
    *(LAS u32x2*)(base + elem_off * 2) = (u32x2){cvt_pk_bf16(re[0], re[1]), cvt_pk_bf16(re[2], re[3])};
    *(LAS u32x2*)(base + FPL + elem_off * 2) = (u32x2){cvt_pk_bf16(im[0], im[1]), cvt_pk_bf16(im[2], im[3])};
}
__device__ __forceinline__ void twid(float& re, float& im, int num, int den_mask, float den_inv, float sgn) {
    const float f = (float)(num & den_mask) * den_inv; const float c = __builtin_amdgcn_cosf(f), sn = sgn * __builtin_amdgcn_sinf(f);
    const float r2 = __builtin_fmaf(re, c, -(im * sn)), i2 = __builtin_fmaf(re, sn, im * c); re = r2; im = i2;
}
constexpr int FTAB = 131072;
__device__ __forceinline__ bf16x8 tab_frag(Frame& F, int id) { return *(const LAS bf16x8*)(F.lds + FTAB + (id * 64 + F.lane) * 16); }
__device__ __forceinline__ void fft_build_table(Frame& F) {
    const int idx = F.lane & 15, g = F.lane >> 4;
    for (int id = 2 * F.wave; id < 2 * F.wave + 2; ++id) { bf16x8 v;
        if (id < 2) v = dft_frag(16, -1.f, 0, idx, g, id & 1);
        else if (id < 4) v = dft_frag(16, 1.f, 0, idx, g, id & 1);
        else if (id < 8) v = dft_frag(32, -1.f, 0, 16 * ((id >> 1) & 1) + idx, g, id & 1);
        else if (id < 12) v = dft_frag(32, 1.f, 16 * (id & 1), idx, g, (id >> 1) & 1);
        else v = dft_frag(32, -1.f, 16, 16 * ((id >> 1) & 1) + idx, g, id & 1);
        *(LAS bf16x8*)(F.lds + FTAB + (id * 64 + F.lane) * 16) = v; }
}
__device__ __forceinline__ void twid4(float (&re)[4], float (&im)[4], int base, int step, int den_mask, float den_inv, float sgn) {
    const float fb = (float)(base & den_mask) * den_inv, fs = (float)(step & den_mask) * den_inv;
    float c = __builtin_amdgcn_cosf(fb), sn = sgn * __builtin_amdgcn_sinf(fb);
    const float cs = __builtin_amdgcn_cosf(fs), ss = sgn * __builtin_amdgcn_sinf(fs);
#pragma unroll
    for (int r = 0; r < 4; ++r) {
        const float r2 = __builtin_fmaf(re[r], c, -(im[r] * sn)), i2 = __builtin_fmaf(re[r], sn, im[r] * c); re[r] = r2; im[r] = i2;
        if (r < 3) { const float c2 = __builtin_fmaf(c, cs, -(sn * ss)), s2 = __builtin_fmaf(c, ss, sn * cs); c = c2; sn = s2; } }
}
template <int NA>
__device__ __forceinline__ void fft_s1(Frame& F, LAS unsigned char* inre, LAS unsigned char* inim, bool imzero) {
    const int lane = F.lane, idx = lane & 15, g = lane >> 4; LAS unsigned char* W = F.lds + FW;
    bf16x8 B[2][2][NA];
#pragma unroll
    for (int hi = 0; hi < 2; ++hi)
#pragma unroll
        for (int part = 0; part < 2; ++part)
#pragma unroll
            for (int sa = 0; sa < NA; ++sa) B[hi][part][sa] = tab_frag(F, (sa ? 12 : 4) + 2 * hi + part);
#pragma unroll
    for (int tq = 0; tq < 2; ++tq) { const int tc = 2 * F.wave + tq;
        bf16x8 A[NA];
#pragma unroll
        for (int sa = 0; sa < NA; ++sa) { const int eo = ((tc * 16 + idx) * (16 * NA)) + 16 * sa + 8 * (g & 1);
            u32x4 z = (u32x4){0u, 0u, 0u, 0u};
            if (g < 2) z = *(const LAS u32x4*)(inre + eo * 2); else if (!imzero) z = *(const LAS u32x4*)(inim + eo * 2);
            A[sa] = __builtin_bit_cast(bf16x8, z); }
#pragma unroll
        for (int hi = 0; hi < 2; ++hi) { facc cr = (facc){0.f, 0.f, 0.f, 0.f}, ci = cr;
#pragma unroll
            for (int sa = 0; sa < NA; ++sa) { cr = fmma_acc(A[sa], B[hi][0][sa], cr); ci = fmma_acc(A[sa], B[hi][1][sa], ci); }
            const int ka = 16 * hi + idx; float re[4], im[4];
#pragma unroll
            for (int r = 0; r < 4; ++r) { re[r] = cr[r]; im[r] = ci[r]; }
            twid4(re, im, 4 * g * ka, ka, 511, 1.0f / 512.0f, -1.f);
            st_quad(W, (ka * 16 + tc) * 16 + 4 * g, re, im); }
    }
}
__device__ __forceinline__ void fft_s2(Frame& F) {
    const int lane = F.lane, idx = lane & 15, g = lane >> 4; LAS unsigned char* W = F.lds + FW;
    const bf16x8 Br = tab_frag(F, 0), Bi = tab_frag(F, 1);
#pragma unroll 2
    for (int kq = 0; kq < 4; ++kq) { const int ka = 4 * F.wave + kq;
        const bf16x8 A = ld_frag(W, (ka * 16 + idx) * 16, g);
        const facc cr = fmma(A, Br), ci = fmma(A, Bi);
        float re[4], im[4];
#pragma unroll
        for (int r = 0; r < 4; ++r) { re[r] = cr[r]; im[r] = ci[r]; }
            twid4(re, im, 4 * g * (ka + 32 * idx), ka + 32 * idx, 8191, 1.0f / 8192.0f, -1.f);
        st_quad(W, (ka * 16 + idx) * 16 + 4 * g, re, im);
    }
}
template <int MODE>
__device__ __forceinline__ void fft_s3(Frame& F, unsigned* KH) {
    const int lane = F.lane, idx = lane & 15, g = lane >> 4; LAS unsigned char* W = F.lds + FW;
    const bf16x8 Ar = tab_frag(F, 0), Ai = tab_frag(F, 1);
#pragma unroll 2
    for (int kq = 0; kq < 4; ++kq) { const int ka = 4 * F.wave + kq;
        const bf16x8 Bd = ld_frag(W, (ka * 16 + idx) * 16, g);
        const facc cr = fmma(Ar, Bd), ci = fmma(Ai, Bd);
        const int eo = (ka * 16 + idx) * 16 + 4 * g;
        if (MODE == 1) { u32x4 o; o.x = pk2(cr[0], ci[0]); o.y = pk2(cr[1], ci[1]); o.z = pk2(cr[2], ci[2]); o.w = pk2(cr[3], ci[3]); *(u32x4*)(KH + eo) = o; }
        else { const u32x4 kv = *(const u32x4*)(KH + eo); const unsigned kw[4] = {kv.x, kv.y, kv.z, kv.w}; float re[4], im[4];
#pragma unroll
            for (int r = 0; r < 4; ++r) { const float kr = bflo(kw[r]), ki = bfhi(kw[r]); re[r] = __builtin_fmaf(cr[r], kr, -(ci[r] * ki)); im[r] = __builtin_fmaf(cr[r], ki, ci[r] * kr); }
            st_quad(W, eo, re, im); }
    }
}
__device__ __forceinline__ void fft_i1(Frame& F) {
    const int lane = F.lane, idx = lane & 15, g = lane >> 4; LAS unsigned char* W = F.lds + FW;
    const bf16x8 Br = tab_frag(F, 2), Bi = tab_frag(F, 3);
#pragma unroll 2
    for (int kq = 0; kq < 4; ++kq) { const int ka = 4 * F.wave + kq;
        const bf16x8 A = ld_frag(W, (ka * 16 + idx) * 16, g);
        const facc cr = fmma(A, Br), ci = fmma(A, Bi);
        float re[4], im[4];
#pragma unroll
        for (int r = 0; r < 4; ++r) { re[r] = cr[r]; im[r] = ci[r]; }
            twid4(re, im, idx * (ka + 128 * g), 32 * idx, 8191, 1.0f / 8192.0f, 1.f);
        st_quad(W, (ka * 16 + idx) * 16 + 4 * g, re, im);
    }
}
__device__ __forceinline__ void fft_mid(Frame& F, const unsigned* KH) {
    const int lane = F.lane, idx = lane & 15, g = lane >> 4; LAS unsigned char* W = F.lds + FW;
    const bf16x8 Fr = tab_frag(F, 0), Fi = tab_frag(F, 1), Gr = tab_frag(F, 2), Gi = tab_frag(F, 3);
#pragma unroll 1
    for (int kp = 0; kp < 2; ++kp) {
        const int ka0 = 4 * F.wave + 2 * kp, eb0 = (ka0 * 16 + idx) * 16, eb1 = eb0 + 256, eo0 = eb0 + 4 * g, eo1 = eb1 + 4 * g;
        const u32x4 kv0 = *(const u32x4*)(KH + eo0), kv1 = *(const u32x4*)(KH + eo1);
        float re[4], im[4];
        {
            const bf16x8 A0 = ld_frag(W, eb0, g), A1 = ld_frag(W, eb1, g);
            const facc cr0 = fmma(A0, Fr), ci0 = fmma(A0, Fi), cr1 = fmma(A1, Fr), ci1 = fmma(A1, Fi);
            __builtin_amdgcn_sched_barrier(0);
#pragma unroll
            for (int r = 0; r < 4; ++r) { re[r] = cr0[r]; im[r] = ci0[r]; }
            twid4(re, im, 4 * g * (ka0 + 32 * idx), ka0 + 32 * idx, 8191, 1.0f / 8192.0f, -1.f); st_quad(W, eo0, re, im);
#pragma unroll
            for (int r = 0; r < 4; ++r) { re[r] = cr1[r]; im[r] = ci1[r]; }
            twid4(re, im, 4 * g * (ka0 + 1 + 32 * idx), ka0 + 1 + 32 * idx, 8191, 1.0f / 8192.0f, -1.f); st_quad(W, eo1, re, im); }
        LDS_ORDER();
        {
            const bf16x8 B0 = ld_frag(W, eb0, g), B1 = ld_frag(W, eb1, g);
            const facc cr0 = fmma(Fr, B0), ci0 = fmma(Fi, B0), cr1 = fmma(Fr, B1), ci1 = fmma(Fi, B1);
            __builtin_amdgcn_sched_barrier(0);
            const unsigned kw0[4] = {kv0.x, kv0.y, kv0.z, kv0.w}, kw1[4] = {kv1.x, kv1.y, kv1.z, kv1.w};
#pragma unroll
            for (int r = 0; r < 4; ++r) { const float kr = bflo(kw0[r]), ki = bfhi(kw0[r]); re[r] = __builtin_fmaf(cr0[r], kr, -(ci0[r] * ki)); im[r] = __builtin_fmaf(cr0[r], ki, ci0[r] * kr); }
            st_quad(W, eo0, re, im);
#pragma unroll
            for (int r = 0; r < 4; ++r) { const float kr = bflo(kw1[r]), ki = bfhi(kw1[r]); re[r] = __builtin_fmaf(cr1[r], kr, -(ci1[r] * ki)); im[r] = __builtin_fmaf(cr1[r], ki, ci1[r] * kr); }
            st_quad(W, eo1, re, im); }
        LDS_ORDER();
        {
            const bf16x8 A0 = ld_frag(W, eb0, g), A1 = ld_frag(W, eb1, g);
            const facc cr0 = fmma(A0, Gr), ci0 = fmma(A0, Gi), cr1 = fmma(A1, Gr), ci1 = fmma(A1, Gi);
            __builtin_amdgcn_sched_barrier(0);
#pragma unroll
            for (int r = 0; r < 4; ++r) { re[r] = cr0[r]; im[r] = ci0[r]; }
            twid4(re, im, idx * (ka0 + 128 * g), 32 * idx, 8191, 1.0f / 8192.0f, 1.f); st_quad(W, eo0, re, im);
#pragma unroll
            for (int r = 0; r < 4; ++r) { re[r] = cr1[r]; im[r] = ci1[r]; }
            twid4(re, im, idx * (ka0 + 1 + 128 * g), 32 * idx, 8191, 1.0f / 8192.0f, 1.f); st_quad(W, eo1, re, im); }
        LDS_ORDER();
    }
}
__device__ __forceinline__ void fft_i2(Frame& F) {
    const int lane = F.lane, idx = lane & 15, g = lane >> 4; LAS unsigned char* W = F.lds + FW; LAS unsigned char* W2 = F.lds + FW2;
    const bf16x8 Br = tab_frag(F, 2), Bi = tab_frag(F, 3);
#pragma unroll 2
    for (int tq = 0; tq < 4; ++tq) { const int t = 4 * F.wave + tq, c = t >> 1, hi = t & 1;
        const bf16x8 A = ld_frag(W, ((16 * hi + idx) * 16 + c) * 16, g);
        const facc cr = fmma(A, Br), ci = fmma(A, Bi);
        float re[4], im[4];
#pragma unroll
        for (int r = 0; r < 4; ++r) { re[r] = cr[r]; im[r] = ci[r]; }
        twid4(re, im, idx * (16 * hi + 4 * g), idx, 511, 1.0f / 512.0f, 1.f);
        st_quad(W2, (c * 16 + idx) * 32 + 16 * hi + 4 * g, re, im);
    }
}
__device__ __forceinline__ void fft_i3_tile(Frame& F, int b, const bf16x8 (&B)[2][2], float (&yre)[4], float (&yim)[4]) {
    const int lane = F.lane, idx = lane & 15, g = lane >> 4; LAS unsigned char* W2 = F.lds + FW2;
    facc cr = (facc){0.f, 0.f, 0.f, 0.f}, ci = cr;
#pragma unroll
    for (int sa = 0; sa < 2; ++sa) { const bf16x8 A = ld_frag(W2, (idx * 16 + b) * 32 + 16 * sa, g); cr = fmma_acc(A, B[0][sa], cr); ci = fmma_acc(A, B[1][sa], ci); }
#pragma unroll
    for (int r = 0; r < 4; ++r) { yre[r] = cr[r] * (1.0f / 8192.0f); yim[r] = ci[r] * (1.0f / 8192.0f); }
}
__device__ __forceinline__ void fft_load_kernel(Frame& F, int order, int ch) {
    const bf16_t* hf = (const bf16_t*)(F.ws + WS_FG) + ((size_t)((order * 2 + 0) * 1024 + ch)) * 4096;
    const bf16_t* hb = (const bf16_t*)(F.ws + WS_FG) + ((size_t)((order * 2 + 1) * 1024 + ch)) * 4096;
    LAS bf16_t* K = (LAS bf16_t*)(F.lds + FW2);
    const int t0 = 8 * F.tid; const u32x4 vf = *(const u32x4*)(hf + t0), vb = *(const u32x4*)(hb + t0);
    const unsigned wf[4] = {vf.x, vf.y, vf.z, vf.w}, wb[4] = {vb.x, vb.y, vb.z, vb.w};
#pragma unroll
    for (int e = 0; e < 8; ++e) { const int t = t0 + e; const unsigned f = (wf[e >> 1] >> (16 * (e & 1))) & 0xffffu, bk = (wb[e >> 1] >> (16 * (e & 1))) & 0xffffu;
        { const int m = t; K[(((m & 15) * 16 + ((m >> 4) & 15)) * 32) + (m >> 8)] = (bf16_t)f; }
        { const int m = (8192 - t) & 8191; const unsigned v = t == 0 ? f : bk; if (t != 0) K[(((m & 15) * 16 + ((m >> 4) & 15)) * 32) + (m >> 8)] = (bf16_t)v; } }
    if (F.tid == 0) { const int m = 4096; K[(((m & 15) * 16 + ((m >> 4) & 15)) * 32) + (m >> 8)] = (bf16_t)0; }
}
__device__ __forceinline__ void fft_commit_u(Frame& F, int c, const HyU& r) {
    const float w0 = F.in[I_CBW][0 * 3072 + c], w1 = F.in[I_CBW][1 * 3072 + c], w2 = F.in[I_CBW][2 * 3072 + c], bb = F.in[I_CBB][c];
    const int s0 = 8 * F.tid, a = s0 >> 8, b4 = (s0 >> 4) & 15, c0 = s0 & 15;
#pragma unroll
    for (int b = 0; b < NB; ++b) {
        float x[10]; x[0] = bf2f(r.pvb[b]); x[1] = bflo(r.mv[b].x); x[2] = bfhi(r.mv[b].x); x[3] = bflo(r.mv[b].y); x[4] = bfhi(r.mv[b].y); x[5] = bflo(r.mv[b].z); x[6] = bfhi(r.mv[b].z); x[7] = bflo(r.mv[b].w); x[8] = bfhi(r.mv[b].w); x[9] = bf2f(r.nvb[b]);
        LAS bf16_t* row = (LAS bf16_t*)(F.lds + FU + b * 8192);
#pragma unroll
        for (int e = 0; e < 8; e += 2) { const unsigned zz = cvt_pk_bf16(bb + w0 * x[e] + w1 * x[e + 1] + w2 * x[e + 2], bb + w0 * x[e + 1] + w1 * x[e + 2] + w2 * x[e + 3]);
            row[((c0 + e) * 16 + b4) * 16 + a] = (bf16_t)zz; row[((c0 + e + 1) * 16 + b4) * 16 + a] = (bf16_t)(zz >> 16); }
    }
}
struct GateRaw { u32x2 mv; bf16_t pv, nv; };
__device__ __forceinline__ void fft_gate_load(Frame& F, int part, int batch, int c, int t, GateRaw& q) {
    const bf16_t* src = (const bf16_t*)(F.ws + WS_HYT) + ((size_t)((part * NB + batch) * DM + c)) * SEQ;
    q.mv = *(const u32x2*)(src + t); q.pv = src[t > 0 ? t - 1 : 0]; q.nv = src[(t + 4 < SEQ) ? t + 4 : SEQ - 1];
}
__device__ __forceinline__ void fft_gate_eval(const GateRaw& q, int t, float w0, float w1, float w2, float bb, float (&gq)[4]) {
    const float pv = t > 0 ? bf2f(q.pv) : 0.f, nv = (t + 4 < SEQ) ? bf2f(q.nv) : 0.f;
    const float x[6] = {pv, bflo(q.mv.x), bfhi(q.mv.x), bflo(q.mv.y), bfhi(q.mv.y), nv};
#pragma unroll
    for (int e = 0; e < 4; ++e) gq[e] = bb + w0 * x[e] + w1 * x[e + 1] + w2 * x[e + 2];
}
__device__ __forceinline__ void hyena_channel_fft(Frame& F, int c, int it, int cnext, bf16_t* UBT, HyU& pu) {
    const int lane = F.lane, idx = lane & 15, g = lane >> 4;
    unsigned* KHbase = (unsigned*)(F.ws + 456 * MiB) + ((size_t)blockIdx.x * 8 + it * 2) * 8192;
    __syncthreads();
    fft_commit_u(F, c, pu);
    if (cnext >= 0) hy_fetch_u(F, 0, cnext, pu);
    bf16x8 B3[2][2];
#pragma unroll
    for (int part = 0; part < 2; ++part)
#pragma unroll
        for (int sa = 0; sa < 2; ++sa) B3[part][sa] = tab_frag(F, 8 + 2 * part + sa);
    for (int order = 0; order < 2; ++order) {
        unsigned* KH = KHbase + order * 8192;
        const int gp = 1 + order;
        const float w0 = F.in[I_CBW][0 * 3072 + gp * 1024 + c], w1 = F.in[I_CBW][1 * 3072 + gp * 1024 + c], w2 = F.in[I_CBW][2 * 3072 + gp * 1024 + c], bb = F.in[I_CBB][gp * 1024 + c];
        __syncthreads();
        fft_load_kernel(F, order, c);
        LDS_WAIT(); __syncthreads();
        fft_s1<2>(F, F.lds + FW2, F.lds + FW2, true);
        LDS_WAIT(); __syncthreads();
        fft_s2(F);
        LDS_WAIT(); __syncthreads();
        fft_s3<1>(F, KH);
        VM_WAIT(); __syncthreads();
        for (int p = 0; p < 4; ++p) {
            fft_s1<1>(F, F.lds + FU + (2 * p) * 8192, F.lds + FU + (2 * p + 1) * 8192, false);
            LDS_WAIT(); __syncthreads();
            fft_mid(F, KH);
            LDS_WAIT(); __syncthreads();
            GateRaw gq[2][2];
#pragma unroll
            for (int bq = 0; bq < 2; ++bq) { const int t = 256 * idx + 16 * (2 * F.wave + bq) + 4 * g; fft_gate_load(F, gp, 2 * p, c, t, gq[bq][0]); fft_gate_load(F, gp, 2 * p + 1, c, t, gq[bq][1]); }
            __builtin_amdgcn_sched_barrier(0);
            fft_i2(F);
            LDS_WAIT(); __syncthreads();
#pragma unroll
            for (int bq = 0; bq < 2; ++bq) { const int b = 2 * F.wave + bq;
                float yre[4], yim[4], g0[4], g1[4];
                const int t = 256 * idx + 16 * b + 4 * g;
                fft_i3_tile(F, b, B3, yre, yim);
                fft_gate_eval(gq[bq][0], t, w0, w1, w2, bb, g0); fft_gate_eval(gq[bq][1], t, w0, w1, w2, bb, g1);
                if (order == 0) {
                    LAS bf16_t* r0 = (LAS bf16_t*)(F.lds + FU + (2 * p) * 8192); LAS bf16_t* r1 = (LAS bf16_t*)(F.lds + FU + (2 * p + 1) * 8192);
#pragma unroll
                    for (int r = 0; r < 4; ++r) { const int eo = ((4 * g + r) * 16 + b) * 16 + idx; const unsigned zz = cvt_pk_bf16(g0[r] * yre[r], g1[r] * yim[r]); r0[eo] = (bf16_t)zz; r1[eo] = (bf16_t)(zz >> 16); }
                } else {
                    *(u32x2*)(UBT + ((size_t)((2 * p) * DM + c)) * SEQ + t) = (u32x2){cvt_pk_bf16(g0[0] * yre[0], g0[1] * yre[1]), cvt_pk_bf16(g0[2] * yre[2], g0[3] * yre[3])};
                    *(u32x2*)(UBT + ((size_t)((2 * p + 1) * DM + c)) * SEQ + t) = (u32x2){cvt_pk_bf16(g1[0] * yim[0], g1[1] * yim[1]), cvt_pk_bf16(g1[2] * yim[2], g1[3] * yim[3])};
                }
            }
            LDS_WAIT(); __syncthreads();
        }
    }
}
__device__ __forceinline__ void hyena_phase_fft(Frame& F, bf16_t* UBT) {
    __syncthreads();
    fft_build_table(F);
    LDS_WAIT(); __syncthreads();
    HyU pu;
    if (F.vcu < DM) hy_fetch_u(F, 0, F.vcu, pu);
    int it = 0;
    for (int c = F.vcu; c < DM; c += F.G, ++it) hyena_channel_fft(F, c, it & 3, (c + F.G < DM) ? c + F.G : -1, UBT, pu);
    __syncthreads();
}
__device__ __forceinline__ void ub_transpose_phase(Frame& F) {
    const bf16_t* UBT = (const bf16_t*)(F.ws + WS_HYT); bf16_t* UB = (bf16_t*)(F.ws + WS_HYT + 64 * MiB);
    LAS bf16_t* tile = (LAS bf16_t*)(F.lds + F.wave * 16384);
    const int gw = F.vcu * NWAVES + F.wave, NGW = F.G * NWAVES, lane = F.lane;
    for (int it = gw; it < NB * 16 * 64; it += NGW) {
        const int b = it >> 10, cb = (it >> 6) & 15, sb = it & 63, c0 = cb * 64, s0 = sb * 64;
#pragma unroll
        for (int i = 0; i < 8; ++i) { const int cl = i * 8 + (lane >> 3), pp = lane & 7;
            const u32x4 v = *(const u32x4*)(UBT + ((size_t)(b * DM + c0 + cl)) * SEQ + s0 + 8 * pp);
            const unsigned wv[4] = {v.x, v.y, v.z, v.w};
#pragma unroll
            for (int e = 0; e < 8; ++e) tile[(8 * pp + e) * 66 + cl] = (bf16_t)((wv[e >> 1] >> (16 * (e & 1))) & 0xffffu); }
        LDS_WAIT();
#pragma unroll
        for (int i = 0; i < 8; ++i) { const int sl = i * 8 + (lane >> 3), pp = lane & 7;
            const LAS unsigned* src = (const LAS unsigned*)(tile + sl * 66 + 8 * pp);
            u32x4 v; v.x = src[0]; v.y = src[1]; v.z = src[2]; v.w = src[3];
            *(u32x4*)(UB + ((size_t)(b * SEQ + s0 + sl)) * DM + c0 + 8 * pp) = v; }
        LDS_WAIT();
    }
}

__device__ __forceinline__ void topk_wave(Frame& F, int b, int e);
constexpr int RT_WR = 0, RT_SCR = 65536;
__device__ __forceinline__ void router_row(Frame& F, int m, const float (&gf)[16], const u32x2 (&vin)[4]) {
    const LAS float* wrT = (const LAS float*)(F.lds + RT_WR);
    f32x4 v[4]; float s = 0.f;
#pragma unroll
    for (int j = 0; j < 4; ++j) { v[j] = bf4(vin[j]); s += (v[j].x * v[j].x + v[j].y * v[j].y) + (v[j].z * v[j].z + v[j].w * v[j].w); }
    s = wave_sum(s);
    const float rstd = 1.0f / sqrtf(s * (1.0f / DM) + EPS);
    unsigned* o4 = (unsigned*)(F.ws + WS_H2 + (size_t)m * DM) + F.lane;
#pragma unroll
    for (int j = 0; j < 4; ++j) { v[j].x *= rstd * gf[4 * j + 0]; v[j].y *= rstd * gf[4 * j + 1]; v[j].z *= rstd * gf[4 * j + 2]; v[j].w *= rstd * gf[4 * j + 3];
        o4[64 * j] = pk4_fp8(fp8_clamp(v[j].x), fp8_clamp(v[j].y), fp8_clamp(v[j].z), fp8_clamp(v[j].w)); }
    float acc[16];
#pragma unroll
    for (int e = 0; e < 16; ++e) { float a = 0.f;
#pragma unroll
        for (int j = 0; j < 4; ++j) { const f32x4 wv = *(const LAS f32x4*)(wrT + e * 1024 + 256 * j + 4 * F.lane); a += (v[j].x * wv.x + v[j].y * wv.y) + (v[j].z * wv.z + v[j].w * wv.w); }
        acc[e] = a; if ((e & 3) == 3) asm volatile("" ::: "memory"); }
    const int lane = F.lane; float r8[8], r4[4], r2[2], lgt;
    { const bool up = (lane & 32) != 0;
#pragma unroll
      for (int i = 0; i < 8; ++i) { const float keep = up ? acc[i + 8] : acc[i], send = up ? acc[i] : acc[i + 8]; r8[i] = keep + __shfl_xor(send, 32); } }
    { const bool up = (lane & 16) != 0;
#pragma unroll
      for (int i = 0; i < 4; ++i) { const float keep = up ? r8[i + 4] : r8[i], send = up ? r8[i] : r8[i + 4]; r4[i] = keep + __shfl_xor(send, 16); } }
    { const bool up = (lane & 8) != 0;
#pragma unroll
      for (int i = 0; i < 2; ++i) { const float keep = up ? r4[i + 2] : r4[i], send = up ? r4[i] : r4[i + 2]; r2[i] = keep + __shfl_xor(send, 8); } }
    { const bool up = (lane & 4) != 0; const float keep = up ? r2[1] : r2[0], send = up ? r2[0] : r2[1]; lgt = keep + __shfl_xor(send, 4); }
    lgt += __shfl_xor(lgt, 2); lgt += __shfl_xor(lgt, 1);
    float mx = lgt;
#pragma unroll
    for (int o = 4; o < 64; o <<= 1) mx = fmaxf(mx, __shfl_xor(mx, o));
    const float p = expf(lgt - mx); float den = p;
#pragma unroll
    for (int o = 4; o < 64; o <<= 1) den += __shfl_xor(den, o);
    if ((lane & 3) == 0) { const int ex = ((lane >> 5) & 1) * 8 + ((lane >> 4) & 1) * 4 + ((lane >> 3) & 1) * 2 + ((lane >> 2) & 1);
        const int b = m >> 12, sq = m & 4095; ((float*)(F.ws + WS_AFF))[(size_t)(b * 16 + ex) * SEQ + sq] = p / den; }
}
__device__ __forceinline__ void phase6(Frame& F) {
    LAS float* wrT = (LAS float*)(F.lds + RT_WR);
    __syncthreads();
    for (int idx = F.tid; idx < 16384; idx += NTHREADS) wrT[(idx & 15) * 1024 + (idx >> 4)] = F.in[I_WROUTER][idx];
    LDS_WAIT(); __syncthreads();
    float gf[16];
#pragma unroll
    for (int j = 0; j < 4; ++j) { const f32x4 g4 = *((const f32x4*)F.in[I_GFFN] + 64 * j + F.lane); gf[4 * j] = g4.x; gf[4 * j + 1] = g4.y; gf[4 * j + 2] = g4.z; gf[4 * j + 3] = g4.w; }
#pragma unroll
    for (int j = 0; j < 16; ++j) asm volatile("" : "+v"(gf[j]));
    const int gw = F.vcu * NWAVES + F.wave, NGW = F.G * NWAVES;
    constexpr int I_GU = (DM / 64) * (DFF / 64), I_DN = (DFF / 64) * (DM / 64), I_ALL = NEXP * (2 * I_GU + I_DN);
    const bool tk = (gw & 15) == 0; const int cw = gw - (gw >> 4) - 1, NCW = NGW - (NGW >> 4);
    int it0 = tk ? (1 << 30) : cw;
#define P6_DECODE(q, it0_) do { const int it_ = REPS(13) > 1 ? (it0_) % I_ALL : (it0_); const int e_ = it_ / (2 * I_GU + I_DN); int r_ = it_ % (2 * I_GU + I_DN); \
        if (r_ < I_GU) { q.W = F.in[I_WGATE] + (size_t)e_ * DM * DFF; q.K = DM; q.N = DFF; q.WT = F.ws + WS_WGU + (size_t)e_ * 4096 * DM; q.mode = 1; q.off = 0; q.item = r_; } \
        else if (r_ < 2 * I_GU) { q.W = F.in[I_WUP] + (size_t)e_ * DM * DFF; q.K = DM; q.N = DFF; q.WT = F.ws + WS_WGU + (size_t)e_ * 4096 * DM; q.mode = 1; q.off = 128; q.item = r_ - I_GU; } \
        else { q.W = F.in[I_WDOWN] + (size_t)e_ * DFF * DM; q.K = DFF; q.N = DM; q.WT = F.ws + WS_WD + (size_t)e_ * DM * DFF; q.mode = 0; q.off = 0; q.item = r_ - 2 * I_GU; } } while (0)
    { u32x2 cur[4], nxt[4]; const bf16_t* XM = (const bf16_t*)(F.ws + WS_XMID);
      if (gw < NT) row_load_bf(XM, gw, F.lane, cur);
      for (int m = gw; m < NT; m += NGW) {
#pragma unroll
          for (int j = 0; j < 4; ++j) nxt[j] = cur[j];
          if (m + NGW < NT) row_load_bf(XM, m + NGW, F.lane, nxt);
          const bool has = it0 < I_ALL * REPS(13) && (((m - gw) / NGW) & 1) == 0;
          F8Item q; f32x4 wv[16];
          if (has) { P6_DECODE(q, it0); f8_issue(q, F.lane, wv); }
          router_row(F, m, gf, cur);
          if (has) { f8_finish(q, F.lane, wv); it0 += NCW; }
#pragma unroll
          for (int j = 0; j < 4; ++j) cur[j] = nxt[j]; } }
    unsigned* rows_done = (unsigned*)(F.ws + WS_CTL) + 8192;
    VM_WAIT(); __syncthreads();
    if (F.tid == 0) { __builtin_amdgcn_fence(__ATOMIC_RELEASE, "agent"); asm volatile("s_waitcnt vmcnt(0)" ::: "memory"); (void)__hip_atomic_fetch_add(rows_done, 1u, __ATOMIC_RELAXED, __HIP_MEMORY_SCOPE_AGENT); }
    for (; it0 < I_ALL * REPS(13); it0 += NCW) { F8Item q; f32x4 wv[16]; P6_DECODE(q, it0); f8_issue(q, F.lane, wv); f8_finish(q, F.lane, wv); }
#undef P6_DECODE
    if ((gw & 15) == 0) {
        unsigned sp = 0; unsigned* tmo = (unsigned*)(F.ws + WS_CTL) + 4096 + XB_TMO;
        while ((unsigned)__builtin_amdgcn_readfirstlane((int)__hip_atomic_load(rows_done, __ATOMIC_RELAXED, __HIP_MEMORY_SCOPE_AGENT)) < (unsigned)F.G) {
            __builtin_amdgcn_s_sleep(2); if (++sp > XB_SPIN_CAP) { if (F.lane == 0) atomicAdd(tmo, 1u); break; } }
        __builtin_amdgcn_fence(__ATOMIC_ACQUIRE, "agent"); asm volatile("s_waitcnt vmcnt(0)" ::: "memory");
        for (int p = gw >> 4; p < NB * NEXP; p += NGW >> 4) topk_wave(F, p >> 4, p & 15);
    }
    __syncthreads();
}
__device__ __forceinline__ int block_excl_scan(Frame& F, int x, LAS int* red, int* tot) {
    int inc = x;
#pragma unroll
    for (int o = 1; o < 64; o <<= 1) { const int y = __shfl_up(inc, o); if (F.lane >= o) inc += y; }
    __syncthreads();
    if (F.lane == 63) red[F.wave] = inc;
    LDS_WAIT(); __syncthreads();
    int base = 0, t = 0;
#pragma unroll
    for (int wv = 0; wv < NWAVES; ++wv) { const int c = red[wv]; if (wv < F.wave) base += c; t += c; }
    *tot = t;
    return base + inc - x;
}
__device__ __forceinline__ void topk_block(Frame& F, int b, int e) {
    LAS int* red = (LAS int*)(F.lds);
    const float* aff = (const float*)(F.ws + WS_AFF) + (size_t)(b * 16 + e) * SEQ + 8 * F.tid;
    const f32x4 v0 = *(const f32x4*)aff, v1 = *(const f32x4*)(aff + 4);
    const float v[8] = {v0.x, v0.y, v0.z, v0.w, v1.x, v1.y, v1.z, v1.w};
    unsigned u[8];
#pragma unroll
    for (int i = 0; i < 8; ++i) u[i] = __builtin_bit_cast(unsigned, v[i]);
    unsigned prefix = 0;
    __syncthreads();
    for (int bit = 30; bit >= 0; --bit) {
        const unsigned cand = prefix | (1u << bit); int cnt = 0;
#pragma unroll
        for (int i = 0; i < 8; ++i) cnt += (u[i] >= cand) ? 1 : 0;
#pragma unroll
        for (int o = 1; o < 64; o <<= 1) cnt += __shfl_xor(cnt, o);
        if (F.lane == 0) red[(bit & 1) * 8 + F.wave] = cnt;
        LDS_WAIT(); __syncthreads();
        int tot = 0;
#pragma unroll
        for (int wv = 0; wv < NWAVES; ++wv) tot += red[(bit & 1) * 8 + wv];
        if (tot >= CAP) prefix = cand;
    }
    const unsigned T = prefix;
    int ngt = 0, neq = 0;
#pragma unroll
    for (int i = 0; i < 8; ++i) { ngt += (u[i] > T) ? 1 : 0; neq += (u[i] == T) ? 1 : 0; }
    int tot_gt = 0, tot_eq = 0;
    (void)block_excl_scan(F, ngt, red + 32, &tot_gt);
    int eqr = block_excl_scan(F, neq, red + 48, &tot_eq);
    const int need = CAP - tot_gt;
    bool sel[8]; int nsel = 0;
#pragma unroll
    for (int i = 0; i < 8; ++i) { bool sl = u[i] > T; if (u[i] == T) { sl = eqr < need; ++eqr; } sel[i] = sl; nsel += sl ? 1 : 0; }
    int tot_sel = 0;
    int slot = block_excl_scan(F, nsel, red + 64, &tot_sel);
    int* TOK = (int*)(F.ws + WS_TOK); float* VAL = (float*)(F.ws + WS_VAL); bf16_t* SLOT = (bf16_t*)(F.ws + WS_SLOT);
#pragma unroll
    for (int i = 0; i < 8; ++i) { const int sq = 8 * F.tid + i; unsigned short so = 0xFFFFu;
        if (sel[i]) { TOK[e * 4096 + b * CAP + slot] = b * SEQ + sq; VAL[e * 4096 + b * CAP + slot] = v[i]; so = (unsigned short)slot; ++slot; }
        SLOT[(size_t)(b * SEQ + sq) * 16 + e] = so; }
    __syncthreads();
}
__device__ __forceinline__ int wave_sum_i(int v) {
#pragma unroll
    for (int o = 1; o < 64; o <<= 1) v += __shfl_xor(v, o);
    return v;
}
__device__ __forceinline__ int wave_excl_scan_i(int x, int lane, int* tot) {
    int inc = x;
#pragma unroll
    for (int o = 1; o < 64; o <<= 1) { const int y = __shfl_up(inc, o); if (lane >= o) inc += y; }
    *tot = __shfl(inc, 63);
    return inc - x;
}
__device__ __forceinline__ void topk_wave(Frame& F, int b, int e) {
    const int lane = F.lane;
    const float* aff = (const float*)(F.ws + WS_AFF) + (size_t)(b * 16 + e) * SEQ + 64 * lane;
    unsigned u[64];
#pragma unroll
    for (int q = 0; q < 16; ++q) { const f32x4 v = *(const f32x4*)(aff + 4 * q); const float a0 = v.x, a1 = v.y, a2 = v.z, a3 = v.w;
        u[4 * q] = __float_as_uint(a0); u[4 * q + 1] = __float_as_uint(a1); u[4 * q + 2] = __float_as_uint(a2); u[4 * q + 3] = __float_as_uint(a3); }
    unsigned prefix = 0;
    for (int bit = 30; bit >= 0; --bit) { const unsigned cand = prefix | (1u << bit); int cnt = 0;
#pragma unroll
        for (int i = 0; i < 64; ++i) cnt += (int)((cand - 1u - u[i]) >> 31);
        if (wave_sum_i(cnt) >= CAP) prefix = cand; }
    const unsigned T = prefix; int ngt = 0, nge = 0;
#pragma unroll
    for (int i = 0; i < 64; ++i) { ngt += (int)((T - u[i]) >> 31); nge += (int)((T - 1u - u[i]) >> 31); }
    const int neq = nge - ngt;
    int tot_gt, tot_eq, tot_sel;
    (void)wave_excl_scan_i(ngt, lane, &tot_gt);
    int eqr = wave_excl_scan_i(neq, lane, &tot_eq);
    const int need = CAP - tot_gt;
    int nsel = 0; { int er = eqr;
#pragma unroll
        for (int i = 0; i < 64; ++i) { const int gt = (int)((T - u[i]) >> 31), eq = (int)((T - 1u - u[i]) >> 31) - gt;
            const int room = 1 ^ (int)((unsigned)(need - 1 - er) >> 31);
            nsel += gt | (eq & room); er += eq; } }
    int slot = wave_excl_scan_i(nsel, lane, &tot_sel);
    int* TOK = (int*)(F.ws + WS_TOK); float* VAL = (float*)(F.ws + WS_VAL); bf16_t* SLOT = (bf16_t*)(F.ws + WS_SLOT);
#pragma unroll
    for (int i = 0; i < 64; ++i) { const int sq = 64 * lane + i; const int gt = (int)((T - u[i]) >> 31), eq = (int)((T - 1u - u[i]) >> 31) - gt;
        const int room = 1 ^ (int)((unsigned)(need - 1 - eqr) >> 31); const int sl = gt | (eq & room); eqr += eq;
        if (sl) { TOK[e * 4096 + b * CAP + slot] = b * SEQ + sq; VAL[e * 4096 + b * CAP + slot] = __uint_as_float(u[i]); }
        SLOT[(size_t)(b * SEQ + sq) * 16 + e] = (bf16_t)(sl ? (unsigned)slot : 0xFFFFu); slot += sl;
        asm volatile("" ::: "memory"); }
}
#define FR_SW(s0, s1) {(unsigned)__builtin_amdgcn_readfirstlane((int)s0.x), (unsigned)__builtin_amdgcn_readfirstlane((int)s0.y), (unsigned)__builtin_amdgcn_readfirstlane((int)s0.z), (unsigned)__builtin_amdgcn_readfirstlane((int)s0.w), \
                       (unsigned)__builtin_amdgcn_readfirstlane((int)s1.x), (unsigned)__builtin_amdgcn_readfirstlane((int)s1.y), (unsigned)__builtin_amdgcn_readfirstlane((int)s1.z), (unsigned)__builtin_amdgcn_readfirstlane((int)s1.w)}
__device__ __forceinline__ int fr_issue(Frame& F, int m, u32x4 s0, u32x4 s1, u32x2 (&y0)[4], u32x2 (&y1)[4], u32x2 (&y2)[4], u32x2 (&y3)[4]) {
    const bf16_t* YE = (const bf16_t*)(F.ws + WS_WGU);
    const int b = m >> 12;
    const unsigned sw[8] = FR_SW(s0, s1);
    int k = 0, r0 = 0, r1 = 0, r2 = 0, r3 = 0;
#pragma unroll
    for (int e = 0; e < 16; ++e) { const unsigned sl = (sw[e >> 1] >> (16 * (e & 1))) & 0xffffu;
        if (sl != 0xFFFFu) { const int row = e * 4096 + b * CAP + (int)sl; r0 = k == 0 ? row : r0; r1 = k == 1 ? row : r1; r2 = k == 2 ? row : r2; r3 = k == 3 ? row : r3; ++k; } }
    if (k > 0) { const u32x2* yr = (const u32x2*)(YE + (size_t)r0 * DM) + F.lane;
#pragma unroll
        for (int j = 0; j < 4; ++j) y0[j] = yr[64 * j]; }
    if (k > 1) { const u32x2* yr = (const u32x2*)(YE + (size_t)r1 * DM) + F.lane;
#pragma unroll
        for (int j = 0; j < 4; ++j) y1[j] = yr[64 * j]; }
    if (k > 2) { const u32x2* yr = (const u32x2*)(YE + (size_t)r2 * DM) + F.lane;
#pragma unroll
        for (int j = 0; j < 4; ++j) y2[j] = yr[64 * j]; }
    if (k > 3) { const u32x2* yr = (const u32x2*)(YE + (size_t)r3 * DM) + F.lane;
#pragma unroll
        for (int j = 0; j < 4; ++j) y3[j] = yr[64 * j]; }
    return k;
}
#define FR_ACC(Y) do { _Pragma("unroll") for (int j = 0; j < 4; ++j) { v[j].x += bflo(Y[j].x); v[j].y += bfhi(Y[j].x); v[j].z += bflo(Y[j].y); v[j].w += bfhi(Y[j].y); } } while (0)
__device__ __forceinline__ void fr_accum(f32x4 (&v)[4], const u32x2 (&vin)[4], int k, const u32x2 (&y0)[4], const u32x2 (&y1)[4], const u32x2 (&y2)[4], const u32x2 (&y3)[4]) {
#pragma unroll
    for (int j = 0; j < 4; ++j) v[j] = bf4(vin[j]);
    if (k > 0) FR_ACC(y0);
    if (k > 1) FR_ACC(y1);
    if (k > 2) FR_ACC(y2);
    if (k > 3) FR_ACC(y3);
}
__device__ __forceinline__ void fr_finish(Frame& F, int m, const float (&gf)[16], float* outp, f32x4 (&v)[4], u32x4 s0, u32x4 s1, int k) {
    f32x4* orow = (f32x4*)(outp + (size_t)m * DM) + F.lane;
    if (k > 4) {
        const bf16_t* YE = (const bf16_t*)(F.ws + WS_WGU); const int b = m >> 12; const unsigned sw[8] = FR_SW(s0, s1);
        int kk = 0;
#pragma unroll
        for (int e = 0; e < 16; ++e) { const unsigned sl = (sw[e >> 1] >> (16 * (e & 1))) & 0xffffu;
            if (sl != 0xFFFFu) { if (kk >= 4) { const u32x2* yr = (const u32x2*)(YE + ((size_t)(e * 4096 + b * CAP + (int)sl)) * DM) + F.lane; u32x2 yy[4];
#pragma unroll
                    for (int j = 0; j < 4; ++j) yy[j] = yr[64 * j];
                    FR_ACC(yy); }
                ++kk; } }
    }
    float s = 0.f;
#pragma unroll
    for (int j = 0; j < 4; ++j) s += (v[j].x * v[j].x + v[j].y * v[j].y) + (v[j].z * v[j].z + v[j].w * v[j].w);
    s = wave_sum(s);
    const float rstd = 1.0f / sqrtf(s * (1.0f / DM) + EPS);
#pragma unroll
    for (int j = 0; j < 4; ++j) { f32x4 o; o.x = v[j].x * rstd * gf[4 * j]; o.y = v[j].y * rstd * gf[4 * j + 1]; o.z = v[j].z * rstd * gf[4 * j + 2]; o.w = v[j].w * rstd * gf[4 * j + 3]; orow[64 * j] = o; }
}
#undef FR_ACC
#undef FR_SW

struct Args { const float* in[28]; float* out; unsigned char* ws; int ph_lo, ph_hi; };
constexpr int NPHASE = 11;
__global__ void __launch_bounds__(NTHREADS, 2) mega_fwd(Args args) {
    extern __shared__ __attribute__((aligned(16))) unsigned char lds_raw[];
    Frame F;
    F.lds = (LAS unsigned char*)lds_raw;
    F.tid = threadIdx.x; F.lane = F.tid & 63; F.wave = __builtin_amdgcn_readfirstlane(F.tid >> 6);
    F.G = gridDim.x; { const int bx = blockIdx.x; F.vcu = (F.G % 8 == 0) ? (bx % 8) * (F.G / 8) + bx / 8 : bx; }
#pragma unroll
    for (int i = 0; i < 28; ++i) F.in[i] = args.in[i];
    F.out = args.out; F.ws = args.ws;
    volatile LAS unsigned* MISC = (volatile LAS unsigned*)(F.lds + LDS_MISC);
    if (F.tid < 64) MISC[F.tid] = 0u;
    __syncthreads();
    unsigned* ctl = (unsigned*)(F.ws + WS_CTL);
    XcdBarrier bar = xcd_barrier_post(ctl + 4096, MISC + 8);
    const int lo = args.ph_lo, hi = args.ph_hi;
#ifndef PHASE_MASK
#define PHASE_MASK 0x7ff
#endif
#define IN(k) (((PHASE_MASK >> (k)) & 1) && lo <= (k) && (k) < hi)
#define SEAM(k) do { if (IN(k) && IN((k) + 1)) { xcd_barrier(bar); if (REPS(14) > 1) xcd_barrier(bar); } } while (0)
    const int cblk = blockIdx.x;
    if (IN(0)) phase0(F);
    SEAM(0);
    if (IN(1)) { { ProbG1 p; p.K = DM; p.G = F.G; p.c = cblk; p.xb = (const char*)(F.ws + WS_XB); p.wint = (const char*)(F.ws + WS_WINT);
        p.ax = (bf16_t*)(F.ws + WS_AX); p.gg = (bf16_t*)(F.ws + WS_GG); p.gates = (bf16_t*)F.out; p.hyt = (bf16_t*)(F.ws + WS_HYT); p.rstd = (const float*)(F.ws + WS_RSTD1);
        pg8::gemm_phase(F.lds, p); } }
    SEAM(1);
    if (IN(2)) { for (int rp = 0; rp < REPS(11); ++rp) mixer_a_phase<1>(F);
        for (int rp = 0; rp < REPS(2); ++rp) { bf16_t* ob = (rp + 1 < REPS(2)) ? (bf16_t*)(F.ws + 460 * MiB) : (bf16_t*)(F.ws + WS_HYT);
            if (HYENA_FFT) hyena_phase_fft(F, ob); else hyena_phase(F, ob); } }
    SEAM(2);
    if (IN(3)) { for (int rp = 0; rp < REPS(3); ++rp) mixer_a_phase<2>(F);
        for (int rp = 0; rp < REPS(12); ++rp) ub_transpose_phase(F); }
    SEAM(3);
    if (IN(4)) { { ProbG4 p; p.K = DM; p.G = F.G; p.c = cblk; p.ua = (const char*)(F.ws + WS_XB); p.ub = (const char*)(F.ws + WS_HYT + 64 * MiB);
        p.wa = (const char*)(F.ws + WS_WA); p.wb = (const char*)(F.ws + WS_WB); p.gates = (const bf16_t*)F.out; p.merged = (bf16_t*)(F.ws + WS_AX);
        p.tmp = (f32x4*)(F.ws + WS_GG) + (size_t)cblk * (256 * 256 / 4);
        pg8::gemm_phase(F.lds, p); } }
    SEAM(4);
    if (IN(5)) { { ProbG5 p; p.K = DM; p.G = F.G; p.c = cblk; p.a = (const char*)(F.ws + WS_AX); p.b = (const char*)(F.ws + WS_WO); p.x = F.in[I_X]; p.xmid = (bf16_t*)(F.ws + WS_XMID);
        pg8::gemm_phase(F.lds, p); } }
    SEAM(5);
    if (IN(6)) { for (int rp = 0; rp < REPS(6); ++rp) phase6(F); }
    SEAM(6);
    if (IN(8)) { { ProbG8 p; p.K = DM / 2; p.G = F.G; p.c = cblk; p.h2 = (const char*)(F.ws + WS_H2); p.wgu = (const char*)(F.ws + WS_WGU); p.tok = (const int*)(F.ws + WS_TOK); p.act = F.ws + WS_ACT;
        pg8::gemm_phase(F.lds, p); } }
    SEAM(8);
    if (IN(9)) { { ProbG9 p; p.K = DFF / 2; p.G = F.G; p.c = cblk; p.act = (const char*)(F.ws + WS_ACT); p.wd = (const char*)(F.ws + WS_WD); p.val = (const float*)(F.ws + WS_VAL); p.ye = (bf16_t*)(F.ws + WS_WGU);
        pg8::gemm_phase(F.lds, p); } }
    SEAM(9);
    if (IN(10)) {
        float gf[16];
#pragma unroll
        for (int j = 0; j < 4; ++j) { const f32x4 g4 = *((const f32x4*)F.in[I_GFINAL] + 64 * j + F.lane); gf[4 * j] = g4.x; gf[4 * j + 1] = g4.y; gf[4 * j + 2] = g4.z; gf[4 * j + 3] = g4.w; }
#pragma unroll
    for (int j = 0; j < 16; ++j) asm volatile("" : "+v"(gf[j]));
        const int gw = F.vcu * NWAVES + F.wave, NGW = F.G * NWAVES;
        for (int rp = 0; rp < REPS(10); ++rp) { float* outp = (rp + 1 < REPS(10)) ? (float*)(F.ws + WS_ACT) : F.out;
            const bf16_t* SLOTB = (const bf16_t*)(F.ws + WS_SLOT); const bf16_t* XM = (const bf16_t*)(F.ws + WS_XMID);
            const u32x4 z4 = (u32x4){0u, 0u, 0u, 0u};
            u32x2 cur[4], nxt[4], nn[4]; u32x4 cs0 = z4, cs1 = z4, ns0 = z4, ns1 = z4, nns0, nns1; int ck = 0, nk;
            u32x2 cy0[4], cy1[4], cy2[4], cy3[4], ny0[4], ny1[4], ny2[4], ny3[4];
            if (gw < NT) { row_load_bf(XM, gw, F.lane, cur); cs0 = *(const u32x4*)(SLOTB + (size_t)gw * 16); cs1 = *(const u32x4*)(SLOTB + (size_t)gw * 16 + 8);
                ck = fr_issue(F, gw, cs0, cs1, cy0, cy1, cy2, cy3); }
#pragma unroll
            for (int j = 0; j < 4; ++j) nxt[j] = cur[j];
            if (gw + NGW < NT) { row_load_bf(XM, gw + NGW, F.lane, nxt); ns0 = *(const u32x4*)(SLOTB + (size_t)(gw + NGW) * 16); ns1 = *(const u32x4*)(SLOTB + (size_t)(gw + NGW) * 16 + 8); }
            for (int m = gw; m < NT; m += NGW) {
                f32x4 v[4];
                fr_accum(v, cur, ck, cy0, cy1, cy2, cy3);
                nk = 0;
                if (m + NGW < NT) nk = fr_issue(F, m + NGW, ns0, ns1, ny0, ny1, ny2, ny3);
#pragma unroll
                for (int j = 0; j < 4; ++j) nn[j] = nxt[j];
                nns0 = ns0; nns1 = ns1;
                if (m + 2 * NGW < NT) { row_load_bf(XM, m + 2 * NGW, F.lane, nn); nns0 = *(const u32x4*)(SLOTB + (size_t)(m + 2 * NGW) * 16); nns1 = *(const u32x4*)(SLOTB + (size_t)(m + 2 * NGW) * 16 + 8); }
                fr_finish(F, m, gf, outp, v, cs0, cs1, ck);
#pragma unroll
                for (int j = 0; j < 4; ++j) { cur[j] = nxt[j]; nxt[j] = nn[j]; cy0[j] = ny0[j]; cy1[j] = ny1[j]; cy2[j] = ny2[j]; cy3[j] = ny3[j]; }
                cs0 = ns0; cs1 = ns1; ns0 = nns0; ns1 = nns1; ck = nk; } }
    }
#undef IN
#undef SEAM
}

#ifndef MK_N_LAUNCHES
#define MK_N_LAUNCHES 1
#endif
extern "C" void kernel_launch(void* const* d_in, const int* in_sizes, int n_in, void* d_out, int out_size, void* d_ws, size_t ws_size, hipStream_t stream) {
    static int grid = 0;
    if (grid == 0) {
        if (n_in != 28 || out_size != NT * DM || ws_size < WS_END) { fprintf(stderr, "kernel_launch: unexpected shapes (n_in %d, out %d, ws %zu < %zu)\n", n_in, out_size, ws_size, (size_t)WS_END); grid = -1; return; }
        int dev = 0, cus = 0, per_cu = 0;
        (void)hipGetDevice(&dev); (void)hipDeviceGetAttribute(&cus, hipDeviceAttributeMultiprocessorCount, dev);
        if (hipFuncSetAttribute((const void*)mega_fwd, hipFuncAttributeMaxDynamicSharedMemorySize, LDS_BYTES) != hipSuccess) { fprintf(stderr, "kernel_launch: hipFuncSetAttribute failed\n"); grid = -1; return; }
        if (hipOccupancyMaxActiveBlocksPerMultiprocessor(&per_cu, (const void*)mega_fwd, NTHREADS, LDS_BYTES) != hipSuccess || per_cu < 1) { fprintf(stderr, "kernel_launch: occupancy query says %d\n", per_cu); per_cu = 1; }
        (void)hipGetLastError();
        grid = cus;
    }
    if (grid < 0) return;
    (void)hipMemsetAsync((char*)d_ws + WS_CTL, 0, CTL_BYTES, stream);
    Args a{};
    for (int i = 0; i < 28; ++i) a.in[i] = (const float*)d_in[i];
    a.out = (float*)d_out; a.ws = (unsigned char*)d_ws;
    if (MK_N_LAUNCHES == 1) {
        a.ph_lo = 0; a.ph_hi = NPHASE;
        void* kargs[] = {&a};
        hipError_t e = hipLaunchCooperativeKernel((const void*)mega_fwd, dim3(grid), dim3(NTHREADS), kargs, LDS_BYTES, stream);
        if (e != hipSuccess) fprintf(stderr, "cooperative launch failed: %s (grid %d)\n", hipGetErrorString(e), grid);
    } else {
        for (int p = 0; p < NPHASE; ++p) { a.ph_lo = p; a.ph_hi = p + 1; hipLaunchKernelGGL(mega_fwd, dim3(grid), dim3(NTHREADS), LDS_BYTES, stream, a); }
    }
}
```

```cpp
#include <hip/hip_runtime.h>
#include <cstdio>
#include <cstdint>

#ifndef EPI_REPS
#define EPI_REPS 1
#endif
#ifndef REPEAT_MASK
#define REPEAT_MASK 0
#endif
#define REPS(k) (1 + ((REPEAT_MASK >> (k)) & 1))
#define LAS __attribute__((address_space(3)))
#define GAS __attribute__((address_space(1)))
typedef unsigned short bf16_t;
typedef short bf16x8 __attribute__((ext_vector_type(8)));
typedef float f32x2 __attribute__((ext_vector_type(2)));
typedef int i32x4 __attribute__((ext_vector_type(4)));
typedef int i32x8 __attribute__((ext_vector_type(8)));
typedef float f32x4 __attribute__((ext_vector_type(4)));
typedef float f32x16 __attribute__((ext_vector_type(16)));
typedef unsigned u32x2 __attribute__((ext_vector_type(2)));
typedef unsigned u32x4 __attribute__((ext_vector_type(4)));

constexpr int NB = 8, SEQ = 4096, NT = NB * SEQ, DM = 1024, NEXP = 16, CAP = 512, DFF = 2048;
constexpr int INCOLS = 7168;
constexpr float EPS = 1e-6f;
constexpr int NWAVES = 8, NTHREADS = 512;

constexpr size_t MiB = 1u << 20;
constexpr size_t WS_CTL = 0, CTL_BYTES = 1 * MiB;
constexpr size_t WS_XB = 1 * MiB;
constexpr size_t WS_WINT = 65 * MiB;
constexpr size_t WS_WA = 79 * MiB, WS_WB = 81 * MiB, WS_WO = 83 * MiB;
constexpr size_t WS_FG = 85 * MiB;
constexpr size_t WS_AX = 117 * MiB;
constexpr size_t WS_GG = 181 * MiB;
constexpr size_t WS_HYT = 245 * MiB;
constexpr size_t WS_AGG = 437 * MiB;
constexpr size_t WS_GAGG = 453 * MiB;
constexpr size_t WS_RSTD1 = 455 * MiB;
constexpr size_t WS_H2 = 1 * MiB;
constexpr size_t WS_WD = 65 * MiB;
constexpr size_t WS_WGU = 129 * MiB;
constexpr size_t WS_ACT = 257 * MiB;
constexpr size_t WS_XMID = 385 * MiB;
constexpr size_t WS_AFF = 513 * MiB;
constexpr size_t WS_TOK = 515 * MiB;
constexpr size_t WS_VAL = 515 * MiB + 256 * 1024;
constexpr size_t WS_SLOT = 516 * MiB;
constexpr size_t WS_END = 520 * MiB;

constexpr int LDS_STAGE = 131072;
constexpr int LDS_MISC = 163840 - 1024;
constexpr int LDS_BYTES = 163840;

__device__ __forceinline__ unsigned f2bf(float f) { unsigned u = __builtin_bit_cast(unsigned, f); return (u + 0x7fffu + ((u >> 16) & 1u)) >> 16; }
__device__ __forceinline__ unsigned pk2(float lo, float hi) { return f2bf(lo) | (f2bf(hi) << 16); }
__device__ __forceinline__ float bf2f(unsigned b) { return __builtin_bit_cast(float, b << 16); }
__device__ __forceinline__ float bflo(unsigned w) { return __builtin_bit_cast(float, w << 16); }
__device__ __forceinline__ float bfhi(unsigned w) { return __builtin_bit_cast(float, w & 0xffff0000u); }
__device__ __forceinline__ unsigned cvt_pk_bf16_asm(float lo, float hi) { unsigned r; asm volatile("v_cvt_pk_bf16_f32 %0, %1, %2" : "=v"(r) : "v"(lo), "v"(hi)); return r; }
typedef __bf16 bf16x2_t __attribute__((ext_vector_type(2)));
__device__ __forceinline__ unsigned cvt_pk_bf16(float lo, float hi) { const f32x2 v = {lo, hi}; return __builtin_bit_cast(unsigned, __builtin_convertvector(v, bf16x2_t)); }
__device__ __forceinline__ float wave_sum(float v) {
#pragma unroll
    for (int o = 1; o < 64; o <<= 1) v += __shfl_xor(v, o);
    return v;
}
__device__ __forceinline__ float fast_exp(float x) { return __builtin_amdgcn_exp2f(x * 1.44269504089f); }
__device__ __forceinline__ float fast_rcp(float x) { return __builtin_amdgcn_rcpf(x); }
__device__ __forceinline__ float sigmoidf_(float x) { return fast_rcp(1.0f + fast_exp(-x)); }
__device__ __forceinline__ float gelu_tanh(float x) {
    const float u = 1.5957691216f * (x + 0.044715f * x * x * x);
    return x * sigmoidf_(u);
}
#define LDS_WAIT() asm volatile("s_waitcnt lgkmcnt(0)" ::: "memory")
#define LDS_ORDER() asm volatile("" ::: "memory")
#define VM_WAIT() asm volatile("s_waitcnt vmcnt(0)" ::: "memory")

#define XB_TMO      128
#define XB_XCNT(j)  (256  + 64 * (j))
#define XB_XSUB(j)  (1280 + 64 * (j))
#define XB_XGEN(j)  (2304 + 64 * (j))
#define XB_TOP      3328
#define XB_TOPGEN   3392
#define XCD_BAR_WORDS 3456
#define XB_SPIN_CAP (1u << 20)
__device__ __forceinline__ unsigned xb_ld(unsigned* p)              { return __hip_atomic_load(p, __ATOMIC_RELAXED, __HIP_MEMORY_SCOPE_AGENT); }
__device__ __forceinline__ unsigned xb_add(unsigned* p, unsigned v) { return __hip_atomic_fetch_add(p, v, __ATOMIC_RELAXED, __HIP_MEMORY_SCOPE_AGENT); }
__device__ __forceinline__ unsigned xb_xcc_id() { return (unsigned)__builtin_amdgcn_s_getreg((3 << 11) | 20) & 0xFu; }
#define XB_SPIN(cond, bar) do { unsigned _sp = 0; while (cond) { __builtin_amdgcn_s_sleep(1); \
    if ((++_sp & 255u) == 0u) { if (xb_ld(&(bar)[XB_TMO])) break; if (_sp > XB_SPIN_CAP) { atomicAdd(&(bar)[XB_TMO], 1u); break; } } } } while (0)
struct XcdBarrier { unsigned* bar; unsigned x; volatile LAS unsigned* st; };
__device__ __forceinline__ XcdBarrier xcd_barrier_post(unsigned* bar, volatile LAS unsigned* st) {
    XcdBarrier b; b.bar = bar; b.x = xb_xcc_id(); b.st = st;
    if (threadIdx.x == 0) (void)xb_add(&bar[XB_XCNT(b.x)], 1u);
    return b;
}
__device__ __forceinline__ void xcd_barrier_complete(unsigned* bar, unsigned x, unsigned& nloc, unsigned& nx, unsigned& xmask) {
    const unsigned G = gridDim.x * gridDim.y * gridDim.z;
    unsigned sum, cnt, mine, msk, sp = 0u;
    for (;;) {
        sum = 0u; cnt = 0u; mine = 0u; msk = 0u;
#pragma unroll
        for (unsigned j = 0; j < 16; ++j) { const unsigned c = xb_ld(&bar[XB_XCNT(j)]); sum += c; cnt += (c > 0u) ? 1u : 0u; msk |= (c > 0u) ? (1u << j) : 0u; mine = (j == x) ? c : mine; }
        if (sum == G) break;
        __builtin_amdgcn_s_sleep(1);
        if ((++sp & 255u) == 0u) { if (xb_ld(&bar[XB_TMO])) break; if (sp > XB_SPIN_CAP) { atomicAdd(&bar[XB_TMO], 1u); break; } }
    }
    nloc = mine > 0u ? mine : 1u; nx = cnt > 0u ? cnt : 1u; xmask = msk;
}
__device__ __forceinline__ void xcd_barrier(const XcdBarrier& b) {
    asm volatile("s_waitcnt vmcnt(0)" ::: "memory");
    __syncthreads();
    if (threadIdx.x == 0) {
        unsigned* bar = b.bar;
        __builtin_amdgcn_s_waitcnt(0);
        unsigned nloc = b.st[0], nx = b.st[1], xmask = b.st[2];
        if (nloc == 0u) { xcd_barrier_complete(bar, b.x, nloc, nx, xmask); b.st[0] = nloc; b.st[1] = nx; b.st[2] = xmask; }
        const unsigned old = xb_add(&bar[XB_XSUB(b.x)], 1u);
        const unsigned gen = old / nloc;
        if (old + 1u == (gen + 1u) * nloc) {
            __builtin_amdgcn_fence(__ATOMIC_RELEASE, "agent");
            asm volatile("s_waitcnt vmcnt(0)" ::: "memory");
            const unsigned og = xb_add(&bar[XB_TOP], 1u);
            const unsigned tg = og / nx;
            if (og + 1u == (tg + 1u) * nx) {
#pragma unroll
                for (unsigned j = 0; j < 16; ++j) if ((xmask >> j) & 1u) (void)xb_add(&bar[XB_XGEN(j)], 1u);
            }
            XB_SPIN(xb_ld(&bar[XB_XGEN(b.x)]) == gen, bar);
            __builtin_amdgcn_fence(__ATOMIC_ACQUIRE, "agent");
            asm volatile("s_waitcnt vmcnt(0)" ::: "memory");
        } else {
            XB_SPIN(xb_ld(&bar[XB_XGEN(b.x)]) == gen, bar);
            __builtin_amdgcn_fence(__ATOMIC_ACQUIRE, "agent");
            asm volatile("s_waitcnt vmcnt(0)" ::: "memory");
        }
    }
    __syncthreads();
}

namespace pg8 {
constexpr int BM = 256, BK = 64, HALF = 128, HTB = HALF * BK * 2, STAGE_BYTES = 8 * HTB, NXCD = 8, WGM = 8;
__device__ __forceinline__ int lds_byte(int r, int c) { const int st = (r >> 4) * 2 + (c >> 5), rr = r & 15, cc = c & 31, ob = rr * 64 + cc * 2; return st * 1024 + (ob ^ (((ob >> 9) & 1) << 5)); }
__device__ __forceinline__ void stage_rc(int b, int& R, int& C) { const int st = b / 1024, sb = b % 1024, swz = sb ^ (((sb >> 9) & 1) << 5); R = (st >> 1) * 16 + swz / 64; C = (st & 1) * 32 + (swz % 64) / 2; }
__device__ __forceinline__ int perm32(int rho) { const int n = rho >> 4, i = rho & 15; return 8 * (i >> 2) + 4 * n + (i & 3); }
struct Unit { int pm, pn, g; };
struct Pre { f32x4 a, b, c, d; };
__device__ __forceinline__ i32x8 cat8(bf16x8 a, bf16x8 b) { return __builtin_shufflevector(__builtin_bit_cast(i32x4, a), __builtin_bit_cast(i32x4, b), 0, 1, 2, 3, 4, 5, 6, 7); }
__device__ __forceinline__ void mfma_f8(f32x4& acc, i32x8 a, i32x8 b, int sc) {
    asm volatile("v_mfma_f32_16x16x128_f8f6f4 %0, %1, %2, %0" : "+v"(acc) : "v"(a), "v"(b)); (void)sc; }
__device__ __forceinline__ void mfma_bf(f32x4& acc, bf16x8 a, bf16x8 b) { asm volatile("v_mfma_f32_16x16x32_bf16 %0, %1, %2, %0" : "+v"(acc) : "v"(a), "v"(b)); }
__device__ __forceinline__ void mfma_bfz(f32x4& acc, bf16x8 a, bf16x8 b) { asm volatile("v_mfma_f32_16x16x32_bf16 %0, %1, %2, 0" : "=&v"(acc) : "v"(a), "v"(b)); }
__device__ __forceinline__ void mfma_f8z(f32x4& acc, i32x8 a, i32x8 b, int sc) {
    asm volatile("v_mfma_f32_16x16x128_f8f6f4 %0, %1, %2, 0" : "=&v"(acc) : "v"(a), "v"(b)); (void)sc; }
__device__ __forceinline__ void tile_of(int L, int nM, int nN, int& pm, int& pn) {
    const int nwg = nM * nN; int wgid;
    { const int q = nwg / NXCD, r = nwg % NXCD, xcd = L % NXCD, off = L / NXCD; wgid = (xcd < r ? xcd * (q + 1) : r * (q + 1) + (xcd - r) * q) + off; }
    const int nig = WGM * nN, gid = wgid / nig, fm = gid * WGM, gsz = (nM - fm) < WGM ? (nM - fm) : WGM;
    pm = fm + ((wgid % nig) % gsz); pn = (wgid % nig) / gsz;
}
template <class P>
__device__ __forceinline__ void gemm_phase(LAS unsigned char* lds, const P& pr) {
    constexpr bool GATHER = P::GATHER;
    const int tid = threadIdx.x, wid = __builtin_amdgcn_readfirstlane(tid >> 6), lane = tid & 63, wr = wid >> 2, wc = wid & 3, fr = lane & 15, fq = lane >> 4;
    const int K = pr.K, nt = K / BK;
    unsigned voffB[2]; unsigned vAc[2][2], vAn[2][2]; int RA[2], CA[2];
    constexpr int PG8_TOK = STAGE_BYTES;
#pragma unroll
    for (int i = 0; i < 2; ++i) { int R, C; stage_rc(tid * 16 + i * 8192, R, C); const int Rb = P::PERM ? ((R & ~31) + perm32(R & 31)) : R;
        RA[i] = R; CA[i] = C; vAc[0][i] = (unsigned)(R * K + C) * 2u; vAc[1][i] = vAc[0][i]; vAn[0][i] = vAc[0][i]; vAn[1][i] = vAc[0][i]; voffB[i] = (unsigned)(Rb * K + C) * 2u; }
    const size_t kstep = (size_t)(BK * 2);
    const size_t hstep = (size_t)HALF * K * 2;
    const unsigned ldsw = (unsigned)wid * 1024u;
    const int aoff = lds_byte(wr * 64 + fr, fq * 8), boff = lds_byte(wc * 32 + fr, fq * 8);
#define PG8_SA(b, h) (((b) * 2 + (h)) * HTB)
#define PG8_SB(b, h) ((4 + (b) * 2 + (h)) * HTB)
#define PG8_STAGE(bufoff, gbase, voff) do { _Pragma("unroll") for (int _i = 0; _i < 2; ++_i) \
        __builtin_amdgcn_global_load_lds((const unsigned*)((const char*)(gbase) + (voff)[_i]), (LAS unsigned*)(lds + (bufoff) + ldsw + _i * 8192), 16, 0, 0); } while (0)
#define PG8_STAGE_A(bufoff, gbase, hh, V) PG8_STAGE(bufoff, (gbase) + (GATHER ? (size_t)0 : (size_t)(hh) * hstep), (V)[GATHER ? (hh) : 0])
#define PG8_LDA(dst, b, h) do { _Pragma("unroll") for (int m = 0; m < 4; ++m) _Pragma("unroll") for (int k = 0; k < 2; ++k) dst[m][k] = *(const LAS bf16x8*)(lds + PG8_SA(b, h) + aoff + m * 2048 + k * 1024); } while (0)
#define PG8_LDB(dst, b, h) do { _Pragma("unroll") for (int n = 0; n < 2; ++n) _Pragma("unroll") for (int k = 0; k < 2; ++k) dst[n][k] = *(const LAS bf16x8*)(lds + PG8_SB(b, h) + boff + n * 2048 + k * 1024); } while (0)
#define PG8_MMA(Z, ai, bj, At, Bt) do { __builtin_amdgcn_s_setprio(1); \
        if constexpr (P::FP8) { _Pragma("unroll") for (int m = 0; m < 4; ++m) _Pragma("unroll") for (int n = 0; n < 2; ++n) { \
            if constexpr (Z) pg8::mfma_f8z(acc[ai][bj][m][n], pg8::cat8(Bt[n][0], Bt[n][1]), pg8::cat8(At[m][0], At[m][1]), sc8); \
            else pg8::mfma_f8(acc[ai][bj][m][n], pg8::cat8(Bt[n][0], Bt[n][1]), pg8::cat8(At[m][0], At[m][1]), sc8); } } \
        else { _Pragma("unroll") for (int k = 0; k < 2; ++k) _Pragma("unroll") for (int m = 0; m < 4; ++m) _Pragma("unroll") for (int n = 0; n < 2; ++n) { \
            if ((Z) && k == 0) pg8::mfma_bfz(acc[ai][bj][m][n], Bt[n][k], At[m][k]); else pg8::mfma_bf(acc[ai][bj][m][n], Bt[n][k], At[m][k]); } } \
        __builtin_amdgcn_s_setprio(0); } while (0)
#define PG8_WAIT_V(n) asm volatile("s_waitcnt vmcnt(" #n ")" ::: "memory")
#define PG8_WAIT_L(n) asm volatile("s_waitcnt lgkmcnt(" #n ")" ::: "memory")
#define PG8_BAR __builtin_amdgcn_s_barrier()
#define PG8_SCHED __builtin_amdgcn_sched_barrier(0)
    Unit cur, nxt; int ui = 0;
    if (!pr.next(0, cur)) return;
    int sc8 = 0x7f7f7f7f; asm volatile("" : "+v"(sc8));
    (void)sc8;
    f32x4 acc[2][2][4][2];
    bf16x8 At[4][2], B0[2][2], B1[2][2];
    const char* cA = pr.a_base(cur); const char* cB = pr.b_base(cur);
    if constexpr (GATHER) {
#pragma unroll
        for (int h = 0; h < 2; ++h)
#pragma unroll
            for (int i = 0; i < 2; ++i) vAc[h][i] = pr.gather_off(cur, RA[i] + 128 * h) + (unsigned)CA[i] * 2u;
    }
    PG8_STAGE(PG8_SB(0, 0), cB, voffB); PG8_STAGE_A(PG8_SA(0, 0), cA, 0, vAc); PG8_STAGE(PG8_SB(0, 1), cB + hstep, voffB); PG8_STAGE_A(PG8_SA(0, 1), cA, 1, vAc);
    if (wr == 1) PG8_BAR;
    PG8_WAIT_V(4); PG8_BAR;
    PG8_STAGE(PG8_SB(1, 0), cB + kstep, voffB); PG8_STAGE_A(PG8_SA(1, 0), cA + kstep, 0, vAc); PG8_STAGE(PG8_SB(1, 1), cB + hstep + kstep, voffB);
    PG8_WAIT_V(6); PG8_BAR;
    for (;;) {
        pg8::Pre pre;
        if constexpr (P::HAS_PRE) pr.pre_load(cur, wr, wc, fr, fq, pre);
        const bool has_next = pr.next(ui + 1, nxt);
        const char* nA = has_next ? pr.a_base(nxt) : cA; const char* nB = has_next ? pr.b_base(nxt) : cB;
        if constexpr (GATHER) {
            if (has_next && wid < 4) __builtin_amdgcn_global_load_lds((const unsigned*)(pr.gather_ptr(nxt) + wid * 64 + lane), (LAS unsigned*)(lds + PG8_TOK + wid * 256), 4, 0, 0);
        }
#define PG8_KBODY(Z) { \
            const bool last = (t == nt - 2); \
            const char* a1 = cA + (size_t)(t + 1) * kstep; \
            const char* a2 = last ? nA : cA + (size_t)(t + 2) * kstep; const char* b2 = last ? nB : cB + (size_t)(t + 2) * kstep; \
            const char* a3 = a2 + kstep; const char* b3 = b2 + kstep; \
            unsigned vA2[2][2]; \
            if constexpr (GATHER) { \
                if (last && has_next) { \
_Pragma("unroll") \
                    for (int h = 0; h < 2; ++h) \
_Pragma("unroll") \
                        for (int i = 0; i < 2; ++i) vAn[h][i] = pr.gather_fin(*(volatile LAS int*)(lds + PG8_TOK + (RA[i] + 128 * h) * 4)) + (unsigned)CA[i] * 2u; \
                } \
_Pragma("unroll") \
                for (int h = 0; h < 2; ++h) \
_Pragma("unroll") \
                    for (int i = 0; i < 2; ++i) vA2[h][i] = (last && has_next) ? vAn[h][i] : vAc[h][i]; \
            } else { \
_Pragma("unroll") \
                for (int h = 0; h < 2; ++h) \
_Pragma("unroll") \
                    for (int i = 0; i < 2; ++i) vA2[h][i] = vAc[0][i]; \
            } \
            PG8_LDB(B0, 0, 0); PG8_SCHED; PG8_LDA(At, 0, 0); PG8_STAGE_A(PG8_SA(1, 1), a1, 1, vAc); \
            PG8_WAIT_L(8); PG8_BAR; PG8_WAIT_L(0); PG8_MMA(Z, 0, 0, At, B0); PG8_BAR; PG8_SCHED; \
            PG8_LDB(B1, 0, 1); PG8_STAGE(PG8_SB(0, 0), b2, voffB); \
            PG8_BAR; PG8_WAIT_L(0); PG8_MMA(Z, 0, 1, At, B1); PG8_BAR; \
            PG8_LDA(At, 0, 1); PG8_STAGE_A(PG8_SA(0, 0), a2, 0, vA2); \
            PG8_BAR; PG8_WAIT_L(0); PG8_MMA(Z, 1, 0, At, B0); PG8_BAR; PG8_SCHED; \
            PG8_STAGE(PG8_SB(0, 1), b2 + hstep, voffB); \
            PG8_WAIT_V(6); PG8_BAR; PG8_MMA(Z, 1, 1, At, B1); PG8_BAR; \
            PG8_LDB(B0, 1, 0); PG8_SCHED; PG8_LDA(At, 1, 0); PG8_STAGE_A(PG8_SA(0, 1), a2, 1, vA2); \
            PG8_WAIT_L(8); PG8_BAR; PG8_WAIT_L(0); PG8_MMA(false, 0, 0, At, B0); PG8_BAR; PG8_SCHED; \
            PG8_LDB(B1, 1, 1); PG8_STAGE(PG8_SB(1, 0), b3, voffB); \
            PG8_BAR; PG8_WAIT_L(0); PG8_MMA(false, 0, 1, At, B1); PG8_BAR; \
            PG8_LDA(At, 1, 1); PG8_STAGE_A(PG8_SA(1, 0), a3, 0, vA2); \
            PG8_BAR; PG8_WAIT_L(0); PG8_MMA(false, 1, 0, At, B0); PG8_BAR; PG8_SCHED; \
            PG8_STAGE(PG8_SB(1, 1), b3 + hstep, voffB); \
            PG8_WAIT_V(6); PG8_BAR; PG8_MMA(false, 1, 1, At, B1); PG8_BAR; \
        }
        { constexpr int t = 0; PG8_KBODY(true) }
        for (int t = 2; t < nt; t += 2) PG8_KBODY(false)
#undef PG8_KBODY
        {
            asm volatile("s_nop 15\n\ts_nop 15" ::: "memory");
#pragma unroll
            for (int a = 0; a < 2; ++a)
#pragma unroll
                for (int b = 0; b < 2; ++b)
#pragma unroll
                    for (int m = 0; m < 4; ++m)
#pragma unroll
                        for (int n = 0; n < 2; ++n) asm volatile("" : "+v"(acc[a][b][m][n]));
        }
        pr.epi(acc, cur, wr, wc, fr, fq, pre);
#if EPI_REPS > 1
        if constexpr (P::EPI2) { for (int er = 1; er < EPI_REPS; ++er) { asm volatile("" ::: "memory"); pr.epi(acc, cur, wr, wc, fr, fq, pre); } }
#endif
        if (!has_next) break;
        cur = nxt; cA = nA; cB = nB; ++ui;
        if constexpr (GATHER) {
#pragma unroll
            for (int h = 0; h < 2; ++h)
#pragma unroll
                for (int i = 0; i < 2; ++i) vAc[h][i] = vAn[h][i];
        }
    }
    PG8_WAIT_V(0);
    if (wr == 0) PG8_BAR;
    PG8_BAR;
#undef PG8_SA
#undef PG8_SB
#undef PG8_STAGE
#undef PG8_STAGE_A
#undef PG8_LDA
#undef PG8_LDB
#undef PG8_MMA
#undef PG8_WAIT_V
#undef PG8_WAIT_L
#undef PG8_BAR
#undef PG8_SCHED
}
}

struct Frame {
    LAS unsigned char* lds;
    int tid, lane, wave, vcu, G;
    const float* in[28]; float* out; unsigned char* ws;
};
enum { I_X = 0, I_GMIX, I_WIN, I_CAW, I_CAB, I_LWR, I_LBR, I_LWI, I_LBI, I_LAM, I_WAOUT, I_CBW, I_CBB, I_FW1, I_FB1, I_FW2, I_FB2, I_FW3, I_FFREQ, I_FBIAS, I_WBOUT, I_WO, I_GFFN, I_WROUTER, I_WGATE, I_WUP, I_WDOWN, I_GFINAL };

constexpr float W8_SCALE = 64.0f, W8_INV = 1.0f / 64.0f;
__device__ __forceinline__ float fp8_clamp(float x) { return __builtin_amdgcn_fmed3f(x, -448.0f, 448.0f); }
__device__ __forceinline__ unsigned pk4_fp8(float a, float b, float c, float d) { int w = 0; w = __builtin_amdgcn_cvt_pk_fp8_f32(a, b, w, false); w = __builtin_amdgcn_cvt_pk_fp8_f32(c, d, w, true); return (unsigned)w; }
struct F8Item { const float* W; unsigned char* WT; int K, N, mode, off, item; };
__device__ __forceinline__ void f8_issue(const F8Item& q, int lane, f32x4 (&v)[16]) {
    const int nblk = q.N / 32, kb = q.item / nblk, nb = q.item % nblk, k0 = 128 * kb, n0 = 32 * nb;
    const int r4 = lane >> 3, c4 = (lane & 7) * 4;
#pragma unroll
    for (int i = 0; i < 16; ++i) v[i] = __builtin_nontemporal_load((const f32x4*)(q.W + (size_t)(k0 + 16 * r4 + i) * q.N + n0 + c4));
}
__device__ __forceinline__ void f8_finish(const F8Item& q, int lane, const f32x4 (&v)[16]) {
    const int nblk = q.N / 32, kb = q.item / nblk, nb = q.item % nblk, k0 = 128 * kb, n0 = 32 * nb;
    const int r4 = lane >> 3, c4 = (lane & 7) * 4;
#pragma unroll
    for (int j = 0; j < 4; ++j) { u32x4 o;
#pragma unroll
        for (int qd = 0; qd < 4; ++qd) o[qd] = pk4_fp8(v[4 * qd][j] * W8_SCALE, v[4 * qd + 1][j] * W8_SCALE, v[4 * qd + 2][j] * W8_SCALE, v[4 * qd + 3][j] * W8_SCALE);
        const int nn = n0 + c4 + j; const int row = (q.mode ? (256 * (nn >> 7) + (nn & 127)) : nn) + q.off;
        __builtin_nontemporal_store(o, (u32x4*)(q.WT + (size_t)row * q.K + k0 + 16 * r4)); }
}
__device__ __forceinline__ void transpose_item(const float* W, int K, int N, bf16_t* WT, const float* scale, int mode, int off, LAS unsigned char* scr, int item, int lane) {
    const int nblk = N / 64, kb = item / nblk, nb = item % nblk, k0 = 64 * kb, n0 = 64 * nb;
    const int r4 = lane >> 4, c4 = (lane & 15) * 4;
    f32x4 v[16];
#pragma unroll
    for (int i = 0; i < 16; ++i) v[i] = *(const f32x4*)(W + (size_t)(k0 + 4 * i + r4) * N + n0 + c4);
    float sc[16];
    if (scale) {
#pragma unroll
        for (int i = 0; i < 16; ++i) sc[i] = scale[k0 + 4 * i + r4]; }
#pragma unroll
    for (int i = 0; i < 16; ++i) { const int kk = 4 * i + r4; f32x4 x = v[i]; if (scale) x = x * sc[i];
        LAS unsigned* d = (LAS unsigned*)(scr + kk * 132 + c4 * 2); d[0] = pk2(x.x, x.y); d[1] = pk2(x.z, x.w); }
    LDS_WAIT();
    const int c = lane & 7;
#pragma unroll
    for (int j = 0; j < 8; ++j) { const int n = 8 * j + (lane >> 3); const LAS bf16_t* sp = (const LAS bf16_t*)(scr + (8 * c) * 132 + n * 2);
        u32x4 o; o.x = (unsigned)sp[0] | ((unsigned)sp[66] << 16); o.y = (unsigned)sp[132] | ((unsigned)sp[198] << 16); o.z = (unsigned)sp[264] | ((unsigned)sp[330] << 16); o.w = (unsigned)sp[396] | ((unsigned)sp[462] << 16);
        const int nn = n0 + n; const int row = (mode ? (256 * (nn >> 7) + (nn & 127)) : nn) + off;
        *(u32x4*)(WT + (size_t)row * K + k0 + 8 * c) = o; }
    LDS_WAIT();
}
__device__ __forceinline__ void row_load(const float* base, int m, int lane, f32x4 (&v)[4]) {
    const f32x4* xr = (const f32x4*)(base + (size_t)m * DM) + lane;
#pragma unroll
    for (int j = 0; j < 4; ++j) v[j] = xr[64 * j];
}
__device__ __forceinline__ void row_load_bf(const bf16_t* base, int m, int lane, u32x2 (&v)[4]) {
    const u32x2* xr = (const u32x2*)(base + (size_t)m * DM) + lane;
#pragma unroll
    for (int j = 0; j < 4; ++j) v[j] = xr[64 * j];
}
__device__ __forceinline__ f32x4 bf4(u32x2 w) { return (f32x4){bflo(w.x), bfhi(w.x), bflo(w.y), bfhi(w.y)}; }
__device__ __forceinline__ void p0_row(Frame& F, int m, const f32x4 (&v)[4]) {
    float s = 0.f;
#pragma unroll
    for (int j = 0; j < 4; ++j) s += (v[j].x * v[j].x + v[j].y * v[j].y) + (v[j].z * v[j].z + v[j].w * v[j].w);
    s = wave_sum(s);
    const float rstd = 1.0f / sqrtf(s * (1.0f / DM) + EPS);
    unsigned long long* o8 = (unsigned long long*)((bf16_t*)(F.ws + WS_XB) + (size_t)m * DM) + F.lane;
#pragma unroll
    for (int j = 0; j < 4; ++j) o8[64 * j] = (unsigned long long)pk2(v[j].x, v[j].y) | ((unsigned long long)pk2(v[j].z, v[j].w) << 32);
    if (F.lane == 0) ((float*)(F.ws + WS_RSTD1))[m] = rstd;
}
__device__ __forceinline__ void p0_filter_item(Frame& F, int tb) {
    LAS float* zb = (LAS float*)(F.lds); LAS float* h1 = (LAS float*)(F.lds + 4096); LAS float* h2T = (LAS float*)(F.lds + 8192);
    const float* w1 = F.in[I_FW1]; const float* b1 = F.in[I_FB1]; const float* w2 = F.in[I_FW2]; const float* b2 = F.in[I_FB2];
    const float* w3 = F.in[I_FW3]; const float* freq = F.in[I_FFREQ]; const float* fbias = F.in[I_FBIAS];
    const int t0 = tb * 16;
    for (int idx = F.tid; idx < 16 * 33; idx += NTHREADS) { const int tt = idx / 33, i = idx % 33, t = t0 + tt; float val;
        if (i == 0) val = (float)t * (1.0f / 4095.0f);
        else { const int k = (i - 1) & 15; const float fk = 1e-4f + (float)k * ((15.0f - 1e-4f) / 15.0f); const float w = (6.283185307179586f / 4096.0f) * (float)t; const float ang = w * fk;
            val = (i <= 16) ? cosf(ang) : -sinf(ang); }
        zb[tt * 36 + i] = val; }
    __syncthreads();
    for (int idx = F.tid; idx < 1024; idx += NTHREADS) { const int tt = idx >> 6, k = idx & 63; float s = b1[k];
        for (int i = 0; i < 33; ++i) s += zb[tt * 36 + i] * w1[i * 64 + k];
        h1[tt * 64 + k] = sinf(freq[k] * s); }
    __syncthreads();
    for (int idx = F.tid; idx < 1024; idx += NTHREADS) { const int tt = idx >> 6, k = idx & 63; float s = b2[k];
        for (int j = 0; j < 64; ++j) s += h1[tt * 64 + j] * w2[j * 64 + k];
        h2T[k * 16 + tt] = sinf(freq[64 + k] * s); }
    __syncthreads();
    const float min_decay = -3.0701134573f, max_decay = -15.3505672865f;
    bf16_t* FG = (bf16_t*)(F.ws + WS_FG);
    const int g = F.lane >> 4, j16 = F.lane & 15;
    float afr[16];
#pragma unroll
    for (int st = 0; st < 16; ++st) afr[st] = h2T[(4 * st + g) * 16 + j16];
#pragma unroll 1
    for (int blk = 0; blk < 8; ++blk) {
        const int col0 = 512 * F.wave + 64 * blk + 4 * j16;
        f32x4 bw[16];
#pragma unroll
        for (int st = 0; st < 16; ++st) bw[st] = *(const f32x4*)(w3 + (size_t)(4 * st + g) * 4096 + col0);
        __builtin_amdgcn_sched_barrier(0);
        f32x4 acc[4];
#pragma unroll
        for (int q = 0; q < 4; ++q) acc[q] = (f32x4){0.f, 0.f, 0.f, 0.f};
#pragma unroll
        for (int st = 0; st < 16; ++st)
#pragma unroll
            for (int q = 0; q < 4; ++q) acc[q] = __builtin_amdgcn_mfma_f32_16x16x4f32(afr[st], bw[st][q], acc[q], 0, 0, 0);
#pragma unroll
        for (int q = 0; q < 4; ++q) { const int col = col0 + q, n = col >> 11, dir = (col >> 10) & 1, c = col & 1023;
            const float dl = fabsf(min_decay + (float)c * ((max_decay - min_decay) / 1023.0f)) * -1.44269504089f;
            float o[4];
#pragma unroll
            for (int r = 0; r < 4; ++r) { const int t = t0 + 4 * g + r; o[r] = acc[q][r] * __builtin_amdgcn_exp2f((float)t * (1.0f / 4095.0f) * dl); }
            if (dir == 0 && t0 == 0 && g == 0) o[0] += fbias[n * 1024 + c];
            u32x2 w; w.x = cvt_pk_bf16(o[0], o[1]); w.y = cvt_pk_bf16(o[2], o[3]);
            *(u32x2*)(FG + ((size_t)((n * 2 + dir) * 1024 + c)) * 4096 + t0 + 4 * g) = w; }
    }
    __syncthreads();
}
__device__ __forceinline__ void p0_streaming(Frame& F) {
    LAS unsigned char* scr = F.lds + F.wave * 16384;
    const int gw = F.vcu * NWAVES + F.wave, NGW = F.G * NWAVES;
    constexpr int I_IN = (DM / 64) * (INCOLS / 64), I_SQ = (DM / 64) * (DM / 64);
    for (int it = gw; it < (I_IN + 3 * I_SQ) * REPS(0); it += NGW) {
        int r = REPS(0) > 1 ? it % (I_IN + 3 * I_SQ) : it;
        if (r < I_IN) { transpose_item(F.in[I_WIN], DM, INCOLS, (bf16_t*)(F.ws + WS_WINT), F.in[I_GMIX], 0, 0, scr, r, F.lane); continue; } r -= I_IN;
        if (r < I_SQ) { transpose_item(F.in[I_WAOUT], DM, DM, (bf16_t*)(F.ws + WS_WA), nullptr, 0, 0, scr, r, F.lane); continue; } r -= I_SQ;
        if (r < I_SQ) { transpose_item(F.in[I_WBOUT], DM, DM, (bf16_t*)(F.ws + WS_WB), nullptr, 0, 0, scr, r, F.lane); continue; } r -= I_SQ;
        transpose_item(F.in[I_WO], DM, DM, (bf16_t*)(F.ws + WS_WO), nullptr, 0, 0, scr, r, F.lane);
    }
    { f32x4 cur[4], nxt[4];
      if (gw < NT) row_load(F.in[I_X], gw, F.lane, cur);
      for (int m0 = gw; m0 < NT * REPS(0); m0 += NGW) { const int m = REPS(0) > 1 ? m0 % NT : m0, mn = REPS(0) > 1 ? (m0 + NGW) % NT : m0 + NGW;
#pragma unroll
          for (int j = 0; j < 4; ++j) nxt[j] = cur[j];
          if (m0 + NGW < NT * REPS(0)) row_load(F.in[I_X], mn, F.lane, nxt);
          p0_row(F, m, cur);
#pragma unroll
          for (int j = 0; j < 4; ++j) cur[j] = nxt[j]; } }
}
__device__ __forceinline__ void phase0(Frame& F) {
    if ((F.vcu & 1) == 0) { for (int tb = F.vcu; tb < 256 * REPS(15) * REPS(0); tb += F.G) p0_filter_item(F, tb & 255); __syncthreads(); p0_streaming(F); }
    else { p0_streaming(F); __syncthreads(); for (int tb = F.vcu; tb < 256 * REPS(15) * REPS(0); tb += F.G) p0_filter_item(F, tb & 255); }
}

using pg8::Unit;
typedef f32x4 Acc[2][2][4][2];
struct ProbG1 {
    static constexpr bool PERM = true, GATHER = false, FP8 = false, EPI2 = true, HAS_PRE = true; static constexpr int EPI_ST = 16;
    int K, G, c; const char* xb; const char* wint; bf16_t* ax; bf16_t* gg; bf16_t* gates; bf16_t* hyt; const float* rstd;
    __device__ __forceinline__ bool next(int i, Unit& u) const {
        int L = i * G + c; if (L >= (2048 + 1536) * REPS(1)) return false; if (REPS(1) > 1) L %= 2048 + 1536;
        if (L < 2048) { u.g = 0; pg8::tile_of(L, 128, 16, u.pm, u.pn); } else { u.g = 1; pg8::tile_of(L - 2048, 12, 128, u.pm, u.pn); }
        return true; }
    __device__ __forceinline__ const char* a_base(const Unit& u) const { return u.g == 0 ? xb + (size_t)u.pm * 256 * 2048 : wint + (size_t)(2048 + 256 * u.pm) * 2048; }
    __device__ __forceinline__ const char* b_base(const Unit& u) const { return u.g == 0 ? wint + (size_t)(u.pn < 8 ? 256 * u.pn : 256 * u.pn + 3072) * 2048 : xb + (size_t)u.pn * 256 * 2048; }
    __device__ __forceinline__ unsigned gather_off(const Unit&, int) const { return 0u; }
    __device__ __forceinline__ const int* gather_ptr(const Unit&) const { return nullptr; }
    __device__ __forceinline__ unsigned gather_fin(int) const { return 0u; }
    __device__ __forceinline__ void pre_load(const Unit& u, int wr, int wc, int fr, int fq, pg8::Pre& pre) const {
        if (u.g == 0) { const float* p = rstd + u.pm * 256 + wr * 64 + fr;
            pre.a = (f32x4){p[0], p[16], p[32], p[48]}; pre.b = (f32x4){p[128], p[144], p[160], p[176]}; pre.c = pre.a; pre.d = pre.b;
        } else { const float* p = rstd + u.pn * 256 + wc * 32 + 8 * fq;
            pre.a = *(const f32x4*)p; pre.b = *(const f32x4*)(p + 4); pre.c = *(const f32x4*)(p + 128); pre.d = *(const f32x4*)(p + 132); }
    }
    __device__ __forceinline__ void epi(const Acc& acc, const Unit& u, int wr, int wc, int fr, int fq, const pg8::Pre& pre) const {
        if (u.g == 0) {
            const int row0 = u.pm * 256 + wr * 64 + fr, cl = wc * 32 + 8 * fq;
#define P1_EPI_LOOP(DST, BODY) do { _Pragma("unroll") for (int ai = 0; ai < 2; ++ai) _Pragma("unroll") for (int m = 0; m < 4; ++m) { const int row = row0 + ai * 128 + m * 16; const float rs = ai == 0 ? pre.a[m] : pre.b[m]; \
                _Pragma("unroll") for (int bj = 0; bj < 2; ++bj) { float o[8]; bf16_t* dst = DST; \
                    _Pragma("unroll") for (int j = 0; j < 8; ++j) { const float av = acc[ai][bj][m][j >> 2][j & 3]; BODY; } \
                    u32x4 w; w.x = cvt_pk_bf16(o[0], o[1]); w.y = cvt_pk_bf16(o[2], o[3]); w.z = cvt_pk_bf16(o[4], o[5]); w.w = cvt_pk_bf16(o[6], o[7]); \
                    *(u32x4*)dst = w; } } } while (0)
            if (u.pn < 4) { P1_EPI_LOOP(ax + (size_t)row * DM + u.pn * 256 + bj * 128 + cl, o[j] = av * rs); }
            else if (u.pn < 8) {
                constexpr float k0 = -1.5957691216f * 1.44269504089f, k1 = k0 * 0.044715f;
                P1_EPI_LOOP(gg + (size_t)row * DM + (u.pn - 4) * 256 + bj * 128 + cl, { const float x = av * rs; const float w_ = __builtin_fmaf(x * x, k1, k0); o[j] = x * fast_rcp(1.0f + __builtin_amdgcn_exp2f(x * w_)); }); }
            else { P1_EPI_LOOP(gates + (size_t)row * 2048 + (u.pn - 8) * 256 + bj * 128 + cl, o[j] = fast_rcp(1.0f + __builtin_amdgcn_exp2f(av * (rs * -1.44269504089f)))); }
#undef P1_EPI_LOOP
        } else {
            const int ch0 = u.pm * 256 + wr * 64 + fr, tl = u.pn * 256 + wc * 32 + 8 * fq;
            const f32x4 rs[2][2] = {{pre.a, pre.b}, {pre.c, pre.d}};
#pragma unroll
            for (int ai = 0; ai < 2; ++ai)
#pragma unroll
                for (int m = 0; m < 4; ++m) { const int ch = ch0 + ai * 128 + m * 16; const int part = ch >> 10, cc = ch & 1023;
#pragma unroll
                    for (int bj = 0; bj < 2; ++bj) { const int tok = tl + bj * 128; const int b = tok >> 12, s = tok & 4095;
                        const f32x4 v0 = acc[ai][bj][m][0] * rs[bj][0], v1 = acc[ai][bj][m][1] * rs[bj][1];
                        u32x4 w; w.x = cvt_pk_bf16(v0[0], v0[1]); w.y = cvt_pk_bf16(v0[2], v0[3]); w.z = cvt_pk_bf16(v1[0], v1[1]); w.w = cvt_pk_bf16(v1[2], v1[3]);
                        *(u32x4*)(hyt + ((size_t)((part * NB + b) * DM + cc)) * SEQ + s) = w; } }
        }
    }
};
struct ProbG4 {
    static constexpr bool PERM = true, GATHER = false, FP8 = false, EPI2 = false, HAS_PRE = false; static constexpr int EPI_ST = 16;
    int K, G, c; const char* ua; const char* ub; const char* wa; const char* wb; const bf16_t* gates; bf16_t* merged; f32x4* tmp;
    __device__ __forceinline__ bool next(int i, Unit& u) const { int L = (i >> 1) * G + c; if (L >= 512 * REPS(4)) return false; if (REPS(4) > 1) L %= 512; u.g = i & 1; pg8::tile_of(L, 128, 4, u.pm, u.pn); return true; }
    __device__ __forceinline__ const char* a_base(const Unit& u) const { return (u.g == 0 ? ua : ub) + (size_t)u.pm * 256 * 2048; }
    __device__ __forceinline__ const char* b_base(const Unit& u) const { return (u.g == 0 ? wa : wb) + (size_t)u.pn * 256 * 2048; }
    __device__ __forceinline__ unsigned gather_off(const Unit&, int) const { return 0u; }
    __device__ __forceinline__ const int* gather_ptr(const Unit&) const { return nullptr; }
    __device__ __forceinline__ unsigned gather_fin(int) const { return 0u; }
    __device__ __forceinline__ void epi(const Acc& acc, const Unit& u, int wr, int wc, int fr, int fq, const pg8::Pre& pre) const {
        const int row0 = u.pm * 256 + wr * 64 + fr, col0 = u.pn * 256 + wc * 32 + 8 * fq;
        const int goff = u.g == 0 ? 0 : 1024;
        if (u.g == 0) {
            u32x4 ga[2][4][2];
#pragma unroll
            for (int ai = 0; ai < 2; ++ai)
#pragma unroll
                for (int m = 0; m < 4; ++m)
#pragma unroll
                    for (int bj = 0; bj < 2; ++bj) ga[ai][m][bj] = *(const u32x4*)(gates + (size_t)(row0 + ai * 128 + m * 16) * 2048 + col0 + bj * 128);
#pragma unroll
            for (int ai = 0; ai < 2; ++ai)
#pragma unroll
                for (int m = 0; m < 4; ++m) { const int row = row0 + ai * 128 + m * 16;
#pragma unroll
                    for (int bj = 0; bj < 2; ++bj) { const int col = col0 + bj * 128; const u32x4 g4 = ga[ai][m][bj];
                        const f32x4 a0 = acc[ai][bj][m][0], a1 = acc[ai][bj][m][1];
                        u32x4 w;
                        w.x = cvt_pk_bf16_asm(bflo(g4.x) * a0[0], bfhi(g4.x) * a0[1]); w.y = cvt_pk_bf16_asm(bflo(g4.y) * a0[2], bfhi(g4.y) * a0[3]);
                        w.z = cvt_pk_bf16_asm(bflo(g4.z) * a1[0], bfhi(g4.z) * a1[1]); w.w = cvt_pk_bf16_asm(bflo(g4.w) * a1[2], bfhi(g4.w) * a1[3]);
                        *(u32x4*)(merged + (size_t)row * DM + col) = w; } }
            return;
        }
#pragma unroll
        for (int ai = 0; ai < 2; ++ai) {
            u32x4 gv[4][2], pv[4][2];
#pragma unroll
            for (int m = 0; m < 4; ++m) { const int row = row0 + ai * 128 + m * 16;
#pragma unroll
                for (int bj = 0; bj < 2; ++bj) { const int col = col0 + bj * 128;
                    gv[m][bj] = *(const u32x4*)(gates + (size_t)row * 2048 + goff + col);
                    pv[m][bj] = (u32x4){0u, 0u, 0u, 0u};
                    if (u.g != 0) pv[m][bj] = *(const u32x4*)(merged + (size_t)row * DM + col); } }
#pragma unroll
            for (int m = 0; m < 4; ++m) { const int row = row0 + ai * 128 + m * 16;
#pragma unroll
                for (int bj = 0; bj < 2; ++bj) { const int col = col0 + bj * 128; const u32x4 g4 = gv[m][bj], p4 = pv[m][bj];
                    const f32x4 a0 = acc[ai][bj][m][0], a1 = acc[ai][bj][m][1];
                    u32x4 w;
                    w.x = cvt_pk_bf16_asm(bflo(g4.x) * a0[0] + bflo(p4.x), bfhi(g4.x) * a0[1] + bfhi(p4.x));
                    w.y = cvt_pk_bf16_asm(bflo(g4.y) * a0[2] + bflo(p4.y), bfhi(g4.y) * a0[3] + bfhi(p4.y));
                    w.z = cvt_pk_bf16_asm(bflo(g4.z) * a1[0] + bflo(p4.z), bfhi(g4.z) * a1[1] + bfhi(p4.z));
                    w.w = cvt_pk_bf16_asm(bflo(g4.w) * a1[2] + bflo(p4.w), bfhi(g4.w) * a1[3] + bfhi(p4.w));
                    *(u32x4*)(merged + (size_t)row * DM + col) = w; } }
            asm volatile("" ::: "memory");
        }
    }
};
struct ProbG5 {
    static constexpr bool PERM = true, GATHER = false, FP8 = false, EPI2 = true, HAS_PRE = false; static constexpr int EPI_ST = 16;
    int K, G, c; const char* a; const char* b; const float* x; bf16_t* xmid;
    __device__ __forceinline__ bool next(int i, Unit& u) const { int L = i * G + c; if (L >= 512 * REPS(5)) return false; if (REPS(5) > 1) L %= 512; u.g = 0; pg8::tile_of(L, 128, 4, u.pm, u.pn); return true; }
    __device__ __forceinline__ const char* a_base(const Unit& u) const { return a + (size_t)u.pm * 256 * 2048; }
    __device__ __forceinline__ const char* b_base(const Unit& u) const { return b + (size_t)u.pn * 256 * 2048; }
    __device__ __forceinline__ unsigned gather_off(const Unit&, int) const { return 0u; }
    __device__ __forceinline__ const int* gather_ptr(const Unit&) const { return nullptr; }
    __device__ __forceinline__ unsigned gather_fin(int) const { return 0u; }
    __device__ __forceinline__ void epi(const Acc& acc, const Unit& u, int wr, int wc, int fr, int fq, const pg8::Pre&) const {
        const int row0 = u.pm * 256 + wr * 64 + fr, col0 = u.pn * 256 + wc * 32 + 8 * fq;
#pragma unroll
        for (int ai = 0; ai < 2; ++ai) {
            f32x4 xv[4][2][2];
#pragma unroll
            for (int m = 0; m < 4; ++m) { const size_t off = (size_t)(row0 + ai * 128 + m * 16) * DM + col0;
#pragma unroll
                for (int bj = 0; bj < 2; ++bj)
#pragma unroll
                    for (int n = 0; n < 2; ++n) xv[m][bj][n] = *(const f32x4*)(x + off + bj * 128 + n * 4); }
#pragma unroll
            for (int m = 0; m < 4; ++m) { const size_t off = (size_t)(row0 + ai * 128 + m * 16) * DM + col0;
#pragma unroll
                for (int bj = 0; bj < 2; ++bj) { const f32x4 v0 = xv[m][bj][0] + acc[ai][bj][m][0], v1 = xv[m][bj][1] + acc[ai][bj][m][1];
                    u32x4 w; w.x = cvt_pk_bf16(v0[0], v0[1]); w.y = cvt_pk_bf16(v0[2], v0[3]); w.z = cvt_pk_bf16(v1[0], v1[1]); w.w = cvt_pk_bf16(v1[2], v1[3]);
                    *(u32x4*)(xmid + off + bj * 128) = w; } }
            asm volatile("" ::: "memory");
        }
    }
};
struct ProbG8 {
    static constexpr bool PERM = true, GATHER = true, FP8 = true, EPI2 = true, HAS_PRE = false; static constexpr int EPI_ST = 8;
    int K, G, c; const char* h2; const char* wgu; const int* tok; unsigned char* act;
    __device__ __forceinline__ bool next(int i, Unit& u) const { int L = i * G + c; if (L >= 4096 * REPS(8)) return false; if (REPS(8) > 1) L %= 4096; u.g = L >> 8; pg8::tile_of(L & 255, 16, 16, u.pm, u.pn); return true; }
    __device__ __forceinline__ const char* a_base(const Unit&) const { return h2; }
    __device__ __forceinline__ const char* b_base(const Unit& u) const { return wgu + (size_t)(u.g * 4096 + 256 * u.pn) * 1024; }
    __device__ __forceinline__ unsigned gather_off(const Unit& u, int row) const { return (unsigned)tok[u.g * 4096 + 256 * u.pm + row] * 1024u; }
    __device__ __forceinline__ const int* gather_ptr(const Unit& u) const { return tok + u.g * 4096 + 256 * u.pm; }
    __device__ __forceinline__ unsigned gather_fin(int raw) const { return (unsigned)raw * 1024u; }
    __device__ __forceinline__ void epi(const Acc& acc, const Unit& u, int wr, int wc, int fr, int fq, const pg8::Pre& pre) const {
        const int row0 = u.pm * 256 + wr * 64 + fr, col0 = u.pn * 128 + wc * 32 + 8 * fq;
#pragma unroll
        for (int ai = 0; ai < 2; ++ai)
#pragma unroll
            for (int m = 0; m < 4; ++m) { const int row = row0 + ai * 128 + m * 16; float o[8];
#pragma unroll
                for (int n = 0; n < 2; ++n)
#pragma unroll
                    for (int j = 0; j < 4; ++j) { const float ag = acc[ai][0][m][n][j], au = acc[ai][1][m][n][j];
                        const float e = __builtin_amdgcn_exp2f(ag * (-1.44269504089f * W8_INV));
                        o[4 * n + j] = fp8_clamp((ag * au) * fast_rcp(__builtin_fmaf(e, 4096.0f, 4096.0f))); }
                u32x2 w; w.x = pk4_fp8(o[0], o[1], o[2], o[3]); w.y = pk4_fp8(o[4], o[5], o[6], o[7]);
                *(u32x2*)(act + ((size_t)(u.g * 4096 + row)) * DFF + col0) = w; }
    }
};
struct ProbG9 {
    static constexpr bool PERM = true, GATHER = false, FP8 = true, EPI2 = true, HAS_PRE = true; static constexpr int EPI_ST = 16;
    int K, G, c; const char* act; const char* wd; const float* val; bf16_t* ye;
    __device__ __forceinline__ bool next(int i, Unit& u) const { int L = i * G + c; if (L >= 1024 * REPS(9)) return false; if (REPS(9) > 1) L %= 1024; u.g = L >> 6; pg8::tile_of(L & 63, 16, 4, u.pm, u.pn); return true; }
    __device__ __forceinline__ const char* a_base(const Unit& u) const { return act + (size_t)(u.g * 4096 + 256 * u.pm) * 2048; }
    __device__ __forceinline__ const char* b_base(const Unit& u) const { return wd + (size_t)(u.g * 1024 + 256 * u.pn) * 2048; }
    __device__ __forceinline__ unsigned gather_off(const Unit&, int) const { return 0u; }
    __device__ __forceinline__ const int* gather_ptr(const Unit&) const { return nullptr; }
    __device__ __forceinline__ unsigned gather_fin(int) const { return 0u; }
    __device__ __forceinline__ void pre_load(const Unit& u, int wr, int, int fr, int, pg8::Pre& pre) const { const int row0 = u.pm * 256 + wr * 64 + fr;
        const float* p = val + u.g * 4096 + row0;
        pre.a = (f32x4){p[0], p[16], p[32], p[48]}; pre.b = (f32x4){p[128], p[144], p[160], p[176]}; pre.c = pre.a; pre.d = pre.b; }
    __device__ __forceinline__ void epi(const Acc& acc, const Unit& u, int wr, int wc, int fr, int fq, const pg8::Pre& pre) const {
        const int row0 = u.pm * 256 + wr * 64 + fr, col0 = u.pn * 256 + wc * 32 + 8 * fq;
#pragma unroll
        for (int ai = 0; ai < 2; ++ai)
#pragma unroll
            for (int m = 0; m < 4; ++m) { const int row = row0 + ai * 128 + m * 16; const float vs = (ai == 0 ? pre.a[m] : pre.b[m]) * W8_INV;
#pragma unroll
                for (int bj = 0; bj < 2; ++bj) { const f32x4 v0 = acc[ai][bj][m][0] * vs, v1 = acc[ai][bj][m][1] * vs;
                    u32x4 w; w.x = cvt_pk_bf16(v0[0], v0[1]); w.y = cvt_pk_bf16(v0[2], v0[3]); w.z = cvt_pk_bf16(v1[0], v1[1]); w.w = cvt_pk_bf16(v1[2], v1[3]);
                    *(u32x4*)(ye + ((size_t)(u.g * 4096 + row)) * DM + col0 + bj * 128) = w; } }
    }
};

constexpr int MA_WT_BYTES = 4 * 64 * 144, MA_SCR = 15744, MA_RAW = 11264, MA_XAT = 4608, MA_CB = 9216;
static_assert(MA_WT_BYTES + 8 * MA_SCR <= LDS_MISC, "mixer-A LDS");
__device__ __forceinline__ void mixer_a_load_w(Frame& F, int head) {
    LAS unsigned char* WT = F.lds;
#pragma unroll 1
    for (int mat = 0; mat < 4; ++mat) {
        const float* src = ((mat & 1) ? F.in[I_LWI] : F.in[I_LWR]) + (size_t)((mat >> 1) * 16 + head) * 4096 + F.tid;
        float v[8];
#pragma unroll
        for (int it = 0; it < 8; ++it) v[it] = src[it * NTHREADS];
#pragma unroll
        for (int it = 0; it < 8; ++it) { const int i = (F.tid >> 6) + 8 * it, j = F.tid & 63;
            *(LAS bf16_t*)(WT + (mat * 64 + j) * 144 + i * 2) = (bf16_t)f2bf(v[it] * -1.44269504089f); }
    }
}
__device__ __forceinline__ void ub_transpose_item(Frame& F, int it, LAS bf16_t* tile);
template <int PASS>
__device__ __forceinline__ void mixer_a_unit(Frame& F, int b, int head, int g, int& tdone) {
    LAS unsigned char* WT = F.lds; LAS unsigned char* scr = F.lds + MA_WT_BYTES + F.wave * MA_SCR;
    LAS unsigned char* raw = scr + MA_RAW; LAS unsigned char* xat = scr + MA_XAT; LAS float* cbuf = (LAS float*)(scr + MA_CB);
    const int lane = F.lane, col = lane & 31, h = lane >> 5;
    const bf16_t* AX = (const bf16_t*)(F.ws + WS_AX); const bf16_t* GG = (const bf16_t*)(F.ws + WS_GG); bf16_t* UA = (bf16_t*)(F.ws + WS_XB);
    f32x4* AGG = (f32x4*)(F.ws + WS_AGG); f32x4* GAGG = (f32x4*)(F.ws + WS_GAGG);
    float cw[2][4], cbias[2], br0[2], br1[2], bi0[2], bi1[2], sp0[2], sp1[2];
#pragma unroll
    for (int nt = 0; nt < 2; ++nt) { const int ch = head * 64 + 32 * nt + col;
#pragma unroll
        for (int k = 0; k < 4; ++k) cw[nt][k] = F.in[I_CAW][k * DM + ch];
        cbias[nt] = F.in[I_CAB][ch];
        br0[nt] = -1.44269504089f * F.in[I_LBR][ch]; br1[nt] = -1.44269504089f * F.in[I_LBR][DM + ch]; bi0[nt] = -1.44269504089f * F.in[I_LBI][ch]; bi1[nt] = -1.44269504089f * F.in[I_LBI][DM + ch];
        sp0[nt] = -8.0f * 1.44269504089f * log1pf(expf(-F.in[I_LAM][ch])); sp1[nt] = -8.0f * 1.44269504089f * log1pf(expf(-F.in[I_LAM][DM + ch])); }
    float cf[2] = {0.f, 0.f};
    float gPf[2] = {1.f, 1.f}, gHf[2] = {0.f, 0.f}, gPb[2] = {1.f, 1.f}, gHb[2] = {0.f, 0.f};
    if (PASS == 2) {
#pragma unroll
        for (int nt = 0; nt < 2; ++nt) { const int ch = head * 64 + 32 * nt + col;
            const f32x2* G2 = (const f32x2*)GAGG; const f32x2* A2 = (const f32x2*)AGG;
            int vb = b, vg = g; asm volatile("" : "+v"(vb), "+v"(vg));
            float c = 0.f;
            { f32x2 gf2[16];
#pragma unroll
              for (int gp = 0; gp < 16; ++gp) gf2[gp] = G2[((size_t)((vb * 16 + gp) * DM + ch)) * 2];
#pragma unroll
              for (int gp = 0; gp < 16; ++gp) { if (gp < g) c = gf2[gp].y + gf2[gp].x * c; } }
            cf[nt] = c;
            float cr = 0.f;
            { f32x2 gb2[16], cb2[8];
#pragma unroll
              for (int gp = 0; gp < 16; ++gp) gb2[gp] = G2[((size_t)((vb * 16 + gp) * DM + ch)) * 2 + 1];
#pragma unroll
              for (int k = 0; k < 8; ++k) cb2[k] = A2[((size_t)((vb * 128 + vg * 8 + k) * DM + ch)) * 2 + 1];
#pragma unroll
              for (int gp = 15; gp >= 0; --gp) { if (gp > g) cr = gb2[gp].y + gb2[gp].x * cr; }
#pragma unroll
              for (int k = 7; k >= 0; --k) { if (h == 0) cbuf[k * 64 + 32 * nt + col] = cr; cr = cb2[k].y + cb2[k].x * cr; } }
            asm volatile("" ::: "memory");
        }
        LDS_WAIT();
    }
    u32x4 pre[5];
#define MA_FETCH(tstart) do { _Pragma("unroll") for (int it = 0; it < 5; ++it) { const int rr = it * 8 + (lane >> 3), piece = lane & 7, s = (tstart) - 2 + rr; \
        pre[it] = (u32x4){0u, 0u, 0u, 0u}; \
        if (rr < 35 && s >= 0 && s < SEQ) pre[it] = *(const u32x4*)(AX + ((size_t)(b * SEQ + s)) * DM + head * 64 + piece * 8); } } while (0)
#define MA_COMMIT() do { _Pragma("unroll") for (int it = 0; it < 5; ++it) { const int rr = it * 8 + (lane >> 3), piece = lane & 7; \
        if (rr < 35) *(LAS u32x4*)(raw + rr * 128 + piece * 16) = pre[it]; } } while (0)
    MA_FETCH(g * 256);
    MA_COMMIT();
    MA_FETCH(g * 256 + 32);
    for (int k = 0; k < 8; ++k) {
        const int chunk = g * 8 + k, t0 = chunk * 32;
        LDS_WAIT();
        float xa[2][16];
#pragma unroll
        for (int nt = 0; nt < 2; ++nt)
#pragma unroll
            for (int q = 0; q < 4; ++q) { float rv[7];
#pragma unroll
                for (int e = 0; e < 7; ++e) rv[e] = bf2f(*(const LAS bf16_t*)(raw + (8 * q + 4 * h + e) * 128 + (32 * nt + col) * 2));
#pragma unroll
                for (int e = 0; e < 4; ++e) { const float v = cbias[nt] + cw[nt][0] * rv[e] + cw[nt][1] * rv[e + 1] + cw[nt][2] * rv[e + 2] + cw[nt][3] * rv[e + 3];
                    xa[nt][4 * q + e] = v; *(LAS bf16_t*)(xat + (8 * q + 4 * h + e) * 144 + (32 * nt + col) * 2) = (bf16_t)cvt_pk_bf16(v, v); } }
        LDS_WAIT();
        bf16x8 afr[4];
#pragma unroll
        for (int ks = 0; ks < 4; ++ks) afr[ks] = *(const LAS bf16x8*)(xat + col * 144 + (16 * ks + 8 * h) * 2);
        if (k < 7) { MA_COMMIT(); if (k < 6) MA_FETCH(t0 + 64); }
        if (PASS == 2 && lane < 32) __builtin_amdgcn_global_load_lds((const unsigned*)(GG + ((size_t)(b * SEQ + t0 + lane)) * DM + head * 64), (LAS unsigned*)(scr + 8192), 4, 0, 0);
        if (PASS == 2 && (k & 1)) {
            const int itp = (F.vcu * NWAVES + F.wave) + tdone * (F.G * NWAVES);
            if (itp < NB * 16 * 64) { const int bn = itp >> 10, cn = ((itp >> 6) & 15) * 64, sn = (itp & 63) * 64;
                __builtin_amdgcn_global_load_lds((const unsigned*)((const bf16_t*)(F.ws + WS_HYT) + ((size_t)(bn * DM + cn + lane)) * SEQ + sn), (LAS unsigned*)(scr + 8448), 4, 0, 0); } }
        float hf[2][16];
#pragma unroll 1
        for (int d = 0; d < 2; ++d) {
#pragma unroll
            for (int nt = 0; nt < 2; ++nt) {
                const float brd = d ? br1[nt] : br0[nt], bid = d ? bi1[nt] : bi0[nt], spd = d ? sp1[nt] : sp0[nt];
                f32x16 ar, aiv;
#pragma unroll
                for (int i = 0; i < 16; ++i) { ar[i] = 0.f; aiv[i] = 0.f; }
#pragma unroll
                for (int ks = 0; ks < 4; ++ks) {
                    const bf16x8 bR = *(const LAS bf16x8*)(WT + ((2 * d + 0) * 64 + 32 * nt + col) * 144 + (16 * ks + 8 * h) * 2);
                    const bf16x8 bI = *(const LAS bf16x8*)(WT + ((2 * d + 1) * 64 + 32 * nt + col) * 144 + (16 * ks + 8 * h) * 2);
                    ar = __builtin_amdgcn_mfma_f32_32x32x16_bf16(afr[ks], bR, ar, 0, 0, 0);
                    aiv = __builtin_amdgcn_mfma_f32_32x32x16_bf16(afr[ks], bI, aiv, 0, 0, 0);
                }
                const float pre0 = aiv[0], pre15 = aiv[15];
#pragma unroll
                for (int i = 0; i < 16; ++i) {
                    float r = fast_rcp(1.0f + __builtin_amdgcn_exp2f(ar[i] + brd)), ig = fast_rcp(1.0f + __builtin_amdgcn_exp2f(aiv[i] + bid));
                    asm("" : "+v"(r)); asm("" : "+v"(ig));
                    float a = __builtin_amdgcn_exp2f(r * spd);
                    asm("" : "+v"(a));
                    float mult = __builtin_amdgcn_sqrtf(__builtin_fmaf(-a, a, 1.0f));
                    asm("" : "+v"(mult));
                    ar[i] = a; aiv[i] = mult * ig * xa[nt][i]; }
                if (t0 == 0 || t0 == SEQ - 32) {
                    if (d == 0 && t0 == 0 && h == 0) aiv[0] = fast_rcp(1.0f + __builtin_amdgcn_exp2f(pre0 + bid)) * xa[nt][0];
                    if (d == 1 && t0 == SEQ - 32 && h == 1) aiv[15] = fast_rcp(1.0f + __builtin_amdgcn_exp2f(pre15 + bid)) * xa[nt][15]; }
            {
                float P[4], H[4], pP[4], pH[4];
#pragma unroll
                for (int q = 0; q < 4; ++q) { float p = 1.f, hh = 0.f;
                    if (d == 0) {
#pragma unroll
                        for (int e = 0; e < 4; ++e) { hh = ar[4 * q + e] * hh + aiv[4 * q + e]; p *= ar[4 * q + e]; }
                    } else {
#pragma unroll
                        for (int e = 3; e >= 0; --e) { hh = ar[4 * q + e] * hh + aiv[4 * q + e]; p *= ar[4 * q + e]; }
                    }
                    P[q] = p; H[q] = hh; pP[q] = __shfl_xor(p, 32); pH[q] = __shfl_xor(hh, 32); }
                float c = (PASS == 2) ? (d == 0 ? cf[nt] : cbuf[k * 64 + 32 * nt + col]) : 0.f;
                float ptot = 1.f, cin[4];
                if (d == 0) {
#pragma unroll
                    for (int q = 0; q < 4; ++q) { const float P1 = h ? pP[q] : P[q], H1 = h ? pH[q] : H[q], P2 = h ? P[q] : pP[q], H2 = h ? H[q] : pH[q];
                        const float c1 = H1 + P1 * c; cin[q] = h ? c1 : c; c = H2 + P2 * c1; ptot *= P1 * P2; }
                } else {
#pragma unroll
                    for (int q = 3; q >= 0; --q) { const float P1 = h ? P[q] : pP[q], H1 = h ? H[q] : pH[q], P2 = h ? pP[q] : P[q], H2 = h ? pH[q] : H[q];
                        const float c1 = H1 + P1 * c; cin[q] = h ? c : c1; c = H2 + P2 * c1; ptot *= P1 * P2; }
                }
                if (PASS == 1) {
                    if (d == 0) { gHf[nt] = c + ptot * gHf[nt]; gPf[nt] *= ptot; cf[nt] = ptot; hf[nt][0] = c; }
                    else { gHb[nt] += gPb[nt] * c; gPb[nt] *= ptot;
                        if (h == 0) AGG[(size_t)(b * 128 + chunk) * DM + head * 64 + 32 * nt + col] = (f32x4){cf[nt], hf[nt][0], ptot, c}; }
                } else {
                    if (d == 0) { cf[nt] = c;
#pragma unroll
                        for (int q = 0; q < 4; ++q) { float hh = cin[q];
#pragma unroll
                            for (int e = 0; e < 4; ++e) { hh = ar[4 * q + e] * hh + aiv[4 * q + e]; ((LAS float*)scr)[(8 * q + 4 * h + e) * 64 + 32 * nt + col] = hh; } }
                    } else {
#pragma unroll
                        for (int q = 0; q < 4; ++q) { float hh = cin[q];
#pragma unroll
                            for (int e = 3; e >= 0; --e) { hh = ar[4 * q + e] * hh + aiv[4 * q + e];
                                LAS float* ps = (LAS float*)scr + (8 * q + 4 * h + e) * 64 + 32 * nt + col; *ps = *ps + hh; } }
                    }
                }
            }
            }
        }
        if (PASS == 2) {
            LDS_WAIT();
            u32x4 gvv[4];
#pragma unroll
            for (int it = 0; it < 4; ++it) gvv[it] = *(const u32x4*)(GG + ((size_t)(b * SEQ + t0 + it * 8 + (lane >> 3))) * DM + head * 64 + (lane & 7) * 8);
#pragma unroll
            for (int it = 0; it < 4; ++it) { const int row = it * 8 + (lane >> 3), piece = lane & 7;
                const f32x4 s0 = *(const LAS f32x4*)(scr + (row * 64 + piece * 8) * 4), s1 = *(const LAS f32x4*)(scr + (row * 64 + piece * 8 + 4) * 4);
                const size_t o = ((size_t)(b * SEQ + t0 + row)) * DM + head * 64 + piece * 8;
                const u32x4 gv = gvv[it];
                u32x4 w; w.x = cvt_pk_bf16(s0.x * bflo(gv.x), s0.y * bfhi(gv.x)); w.y = cvt_pk_bf16(s0.z * bflo(gv.y), s0.w * bfhi(gv.y));
                w.z = cvt_pk_bf16(s1.x * bflo(gv.z), s1.y * bfhi(gv.z)); w.w = cvt_pk_bf16(s1.z * bflo(gv.w), s1.w * bfhi(gv.w));
                *(u32x4*)(UA + o) = w; }
            LDS_WAIT();
            if (k & 1) { const int it = (F.vcu * NWAVES + F.wave) + tdone * (F.G * NWAVES);
                if (it < NB * 16 * 64) { ub_transpose_item(F, it, (LAS bf16_t*)scr); ++tdone; } }
        }
    }
#undef MA_FETCH
#undef MA_COMMIT
    if (PASS == 1 && h == 0) {
#pragma unroll
        for (int nt = 0; nt < 2; ++nt) GAGG[(size_t)(b * 16 + g) * DM + head * 64 + 32 * nt + col] = (f32x4){gPf[nt], gHf[nt], gPb[nt], gHb[nt]};
    }
}
template <int PASS>
__device__ __forceinline__ int mixer_a_phase(Frame& F) {
    int tdone = 0;
    for (int blk = F.vcu; blk < 256; blk += F.G) {
        const int b = blk >> 5, head = (blk >> 1) & 15, gh = blk & 1;
        __syncthreads();
        mixer_a_load_w(F, head);
        LDS_WAIT(); __syncthreads();
        mixer_a_unit<PASS>(F, b, head, gh * 8 + F.wave, tdone);
    }
    __syncthreads();
    return tdone;
}

constexpr int HY_PITCH = 10256, HY_PAD = 512, HY_U = 0, HY_C0 = 82176, HY_COPY = 16640, HY_C1 = HY_C0 + HY_COPY + 68, HY_OFFR = 4160, HY_NEL = 8320;
__device__ __forceinline__ int hy_uaddr(int b, int s) { const int e = s + HY_PAD, q = e >> 3; return b * HY_PITCH + ((q ^ (((q >> 4) & 3) << 2)) << 4) + ((e & 7) << 1); }
struct HyU { u32x4 mv[NB]; unsigned pvb[NB], nvb[NB]; };
struct HyF { u32x4 vf, vb; };
__device__ __forceinline__ void hy_fetch_u(Frame& F, int part, int c, HyU& r) {
    const bf16_t* HYT = (const bf16_t*)(F.ws + WS_HYT); const int s0 = 8 * F.tid;
#pragma unroll
    for (int b = 0; b < NB; ++b) { const bf16_t* src = HYT + ((size_t)((part * NB + b) * DM + c)) * SEQ;
        r.mv[b] = *(const u32x4*)(src + s0); r.pvb[b] = s0 > 0 ? (unsigned)src[s0 - 1] : 0u; r.nvb[b] = (s0 + 8 < SEQ) ? (unsigned)src[s0 + 8] : 0u; }
}
__device__ __forceinline__ void hy_fetch_u_now(Frame& F, int part, int c, HyU& r) {
    const bf16_t* HYT = (const bf16_t*)(F.ws + WS_HYT); const int s0 = 8 * F.tid;
#pragma unroll
    for (int b = 0; b < NB; ++b) { const bf16_t* src = HYT + ((size_t)((part * NB + b) * DM + c)) * SEQ;
        r.mv[b] = *(const u32x4*)(src + s0); r.pvb[b] = (unsigned)src[s0 > 0 ? s0 - 1 : 0]; r.nvb[b] = (unsigned)src[(s0 + 8 < SEQ) ? s0 + 8 : SEQ - 1]; }
#pragma unroll
    for (int b = 0; b < NB; ++b) { r.pvb[b] = s0 > 0 ? r.pvb[b] : 0u; r.nvb[b] = (s0 + 8 < SEQ) ? r.nvb[b] : 0u; }
}
__device__ __forceinline__ void hy_touch_u(Frame& F, int part, int c, LAS unsigned char* dummy) {
    const bf16_t* src = (const bf16_t*)(F.ws + WS_HYT) + ((size_t)((part * NB + F.wave) * DM + c)) * SEQ;
    __builtin_amdgcn_global_load_lds((const unsigned*)(src + F.lane * 64), (LAS unsigned*)(dummy + F.wave * 256), 4, 0, 0);
}
__device__ __forceinline__ void hy_commit_u(Frame& F, int part, int c, const HyU& r) {
    const float w0 = F.in[I_CBW][0 * 3072 + part * 1024 + c], w1 = F.in[I_CBW][1 * 3072 + part * 1024 + c], w2 = F.in[I_CBW][2 * 3072 + part * 1024 + c], bb = F.in[I_CBB][part * 1024 + c];
    const int s0 = 8 * F.tid;
#pragma unroll
    for (int b = 0; b < NB; ++b) {
        float x[10]; x[0] = bf2f(r.pvb[b]); x[1] = bflo(r.mv[b].x); x[2] = bfhi(r.mv[b].x); x[3] = bflo(r.mv[b].y); x[4] = bfhi(r.mv[b].y); x[5] = bflo(r.mv[b].z); x[6] = bfhi(r.mv[b].z); x[7] = bflo(r.mv[b].w); x[8] = bfhi(r.mv[b].w); x[9] = bf2f(r.nvb[b]);
        float o[8];
#pragma unroll
        for (int e = 0; e < 8; ++e) o[e] = bb + w0 * x[e] + w1 * x[e + 1] + w2 * x[e + 2];
        *(LAS u32x4*)(F.lds + HY_U + hy_uaddr(b, s0)) = (u32x4){pk2(o[0], o[1]), pk2(o[2], o[3]), pk2(o[4], o[5]), pk2(o[6], o[7])};
    }
}
__device__ __forceinline__ void hy_put(Frame& F, int i, unsigned v) {
    *(LAS bf16_t*)(F.lds + HY_C0 + 2 * (i + HY_OFFR)) = (bf16_t)v;
    *(LAS bf16_t*)(F.lds + HY_C1 + 2 * (i - 1 + HY_OFFR)) = (bf16_t)v;
}
__device__ __forceinline__ void hy_fetch_f(Frame& F, int order, int c, HyF& r) {
    const bf16_t* hf = (const bf16_t*)(F.ws + WS_FG) + ((size_t)((order * 2 + 0) * 1024 + c)) * 4096;
    const bf16_t* hb = (const bf16_t*)(F.ws + WS_FG) + ((size_t)((order * 2 + 1) * 1024 + c)) * 4096;
    r.vf = *(const u32x4*)(hf + 8 * F.tid); r.vb = *(const u32x4*)(hb + 8 * F.tid);
}
__device__ __forceinline__ void hy_commit_f(Frame& F, const HyF& r) {
    const int t0 = 8 * F.tid;
    const unsigned wf[4] = {r.vf.x, r.vf.y, r.vf.z, r.vf.w}, wb[4] = {r.vb.x, r.vb.y, r.vb.z, r.vb.w};
#pragma unroll
    for (int e = 0; e < 8; ++e) { const unsigned f = (wf[e >> 1] >> (16 * (e & 1))) & 0xffffu, bk = (wb[e >> 1] >> (16 * (e & 1))) & 0xffffu; const int t = t0 + e;
        hy_put(F, -t, f);
        if (t > 0) hy_put(F, t, bk); }
}
__device__ __forceinline__ void hy_zero_filter(Frame& F) {
    for (int i = F.tid; i < (HY_C1 + HY_COPY - HY_C0) / 4; i += NTHREADS) *(LAS unsigned*)(F.lds + HY_C0 + 4 * i) = 0u;
}
struct A4 { unsigned x, y, z, w; } __attribute__((aligned(4)));
__device__ __forceinline__ bf16x8 hy_lda(LAS unsigned char* p) { const LAS unsigned* q = (const LAS unsigned*)p; u32x4 v; v.x = q[0]; v.y = q[1]; v.z = q[2]; v.w = q[3]; return __builtin_bit_cast(bf16x8, v); }
__device__ __forceinline__ bf16x8 hy_ldb(LAS unsigned char* ub, int q) { return *(const LAS bf16x8*)(ub + ((q ^ (((q >> 4) & 3) << 2)) << 4)); }
__device__ __forceinline__ void hy_conv(Frame& F, f32x16 (&acc)[4]) {
    const int lane = F.lane, w = F.wave, r = lane & 31, h = lane >> 5, n = lane & 31, bq = n >> 2, ap = n & 3;
#pragma unroll
    for (int j = 0; j < 4; ++j)
#pragma unroll
        for (int i = 0; i < 16; ++i) acc[j][i] = 0.f;
    const int p = r & 1;
    LAS unsigned char* abase = F.lds + (p ? HY_C1 : HY_C0) + 2 * (8 * h - r - p + HY_OFFR) - 2 * (512 * w - 4080);
    LAS unsigned char* ub = F.lds + HY_U + bq * HY_PITCH;
    const int q0 = 16 * ap + 574 + h;
    bf16x8 Bw[2][4];
    Bw[0][3] = hy_ldb(ub, q0 + 4); Bw[0][2] = hy_ldb(ub, q0 + 8); Bw[0][1] = hy_ldb(ub, q0 + 12);
    Bw[1][3] = hy_ldb(ub, q0 + 2); Bw[1][2] = hy_ldb(ub, q0 + 6); Bw[1][1] = hy_ldb(ub, q0 + 10);
    Bw[0][0] = Bw[0][1]; Bw[1][0] = Bw[1][1];
    bf16x8 an = hy_lda(abase), bn = hy_ldb(ub, q0);
    for (int kk = 0; kk < 288; kk += 8) {
#pragma unroll
        for (int u = 0; u < 8; ++u) {
            const int k = kk + u, par = u & 1, slot = u >> 1;
            const bf16x8 a = an; Bw[par][slot] = bn;
            const int k1 = (k + 1 < 288) ? k + 1 : 287;
            an = hy_lda(abase - 32 * k1); bn = hy_ldb(ub, q0 - 2 * k1);
            __builtin_amdgcn_s_setprio(1);
#pragma unroll
            for (int j = 0; j < 4; ++j) acc[j] = __builtin_amdgcn_mfma_f32_32x32x16_bf16(a, Bw[par][(slot - j) & 3], acc[j], 0, 0, 0);
            __builtin_amdgcn_s_setprio(0);
        }
    }
}
__device__ __forceinline__ void hyena_channel(Frame& F, int c, int cnext, bf16_t* UBT, HyU& pu, HyF& pf) {
    const int lane = F.lane, w = F.wave, h = lane >> 5, n = lane & 31, bq = n >> 2, ap = n & 3;
    f32x16 acc[4];
    __syncthreads();
    hy_commit_u(F, 0, c, pu); hy_commit_f(F, pf);
    LDS_WAIT(); __syncthreads();
    hy_fetch_u(F, 1, c, pu); hy_fetch_f(F, 1, c, pf);
    hy_conv(F, acc);
    __syncthreads();
    hy_commit_u(F, 1, c, pu); hy_commit_f(F, pf);
    LDS_WAIT(); __syncthreads();
#pragma unroll
    for (int j = 0; j < 4; ++j)
#pragma unroll
        for (int qd = 0; qd < 4; ++qd) { const int t = 512 * w + 32 * j + 128 * ap + 8 * qd + 4 * h;
            LAS u32x2* pz = (LAS u32x2*)(F.lds + HY_U + hy_uaddr(bq, t)); const u32x2 xv = *pz;
            u32x2 o; o.x = pk2(bflo(xv.x) * acc[j][4 * qd + 0], bfhi(xv.x) * acc[j][4 * qd + 1]); o.y = pk2(bflo(xv.y) * acc[j][4 * qd + 2], bfhi(xv.y) * acc[j][4 * qd + 3]);
            *pz = o; }
    LDS_WAIT(); __syncthreads();
    hy_fetch_u(F, 2, c, pu);
    hy_conv(F, acc);
    __syncthreads();
    hy_commit_u(F, 2, c, pu);
    LDS_WAIT(); __syncthreads();
    if (cnext >= 0) { hy_fetch_u(F, 0, cnext, pu); hy_fetch_f(F, 0, cnext, pf); }
#pragma unroll
    for (int j = 0; j < 4; ++j)
#pragma unroll
        for (int qd = 0; qd < 4; ++qd) { const int t = 512 * w + 32 * j + 128 * ap + 8 * qd + 4 * h;
            const u32x2 xv = *(const LAS u32x2*)(F.lds + HY_U + hy_uaddr(bq, t));
            u32x2 o; o.x = pk2(bflo(xv.x) * acc[j][4 * qd + 0], bfhi(xv.x) * acc[j][4 * qd + 1]); o.y = pk2(bflo(xv.y) * acc[j][4 * qd + 2], bfhi(xv.y) * acc[j][4 * qd + 3]);
            *(u32x2*)(UBT + ((size_t)(bq * DM + c)) * SEQ + t) = o; }
}
__device__ __forceinline__ void hyena_phase(Frame& F, bf16_t* UBT) {
    __syncthreads();
    for (int i = F.tid; i < (NB * HY_PITCH) / 16; i += NTHREADS) *(LAS u32x4*)(F.lds + HY_U + i * 16) = (u32x4){0u, 0u, 0u, 0u};
    hy_zero_filter(F);
    LDS_WAIT(); __syncthreads();
    HyU pu; HyF pf;
    if (F.vcu < DM) { hy_fetch_u(F, 0, F.vcu, pu); hy_fetch_f(F, 0, F.vcu, pf); }
    for (int c = F.vcu; c < DM; c += F.G) hyena_channel(F, c, (c + F.G < DM) ? c + F.G : -1, UBT, pu, pf);
    __syncthreads();
}

constexpr int FU = 0, FW = 65536, FW2 = 98304, FPL = 16384;
#ifndef HYENA_FFT
#define HYENA_FFT 1
#endif
typedef f32x4 facc;
__device__ __forceinline__ facc fmma(bf16x8 a, bf16x8 b) { return __builtin_amdgcn_mfma_f32_16x16x32_bf16(a, b, (facc){0.f, 0.f, 0.f, 0.f}, 0, 0, 0); }
__device__ __forceinline__ facc fmma_acc(bf16x8 a, bf16x8 b, facc c) { return __builtin_amdgcn_mfma_f32_16x16x32_bf16(a, b, c, 0, 0, 0); }
__device__ __forceinline__ bf16x8 dft_frag(int R, float sgn, int joff, int kidx, int g, int part) {
    u32x4 w; unsigned* pw = (unsigned*)&w; const int half = g >> 1; const float rinv = 1.0f / (float)R;
#pragma unroll
    for (int e2 = 0; e2 < 4; ++e2) { float v[2];
#pragma unroll
        for (int q = 0; q < 2; ++q) { const int j = joff + 8 * (g & 1) + 2 * e2 + q; const float f = (float)((j * kidx) & (R - 1)) * rinv;
            const float c = __builtin_amdgcn_cosf(f), sn = sgn * __builtin_amdgcn_sinf(f);
            v[q] = part == 0 ? (half == 0 ? c : -sn) : (half == 0 ? sn : c); }
        pw[e2] = pk2(v[0], v[1]); }
    return __builtin_bit_cast(bf16x8, w);
}
__device__ __forceinline__ int fsw(int o) { return o ^ ((((o >> 8) ^ (((o >> 12) & 3) * 3)) & 15) << 4); }
__device__ __forceinline__ bf16x8 ld_frag(LAS unsigned char* base, int elem_off, int g) { return *(const LAS bf16x8*)(base + (g >> 1) * FPL + fsw((elem_off + 8 * (g & 1)) * 2)); }
__device__ __forceinline__ void st_quad(LAS unsigned char* base, int elem_off, const float (&re)[4], const float (&im)[4]) {
    const int so = fsw(elem_off * 2);
    *(LAS u32x2*)(base + so) = (u32x2){cvt_pk_bf16(re[0], re[1]), cvt_pk_bf16(re[2], re[3])};
    *(LAS u32x2*)(base + FPL + so) = (u32x2){cvt_pk_bf16(im[0], im[1]), cvt_pk_bf16(im[2], im[3])};
}
__device__ __forceinline__ void twid(float& re, float& im, int num, int den_mask, float den_inv, float sgn) {
    const float f = (float)(num & den_mask) * den_inv; const float c = __builtin_amdgcn_cosf(f), sn = sgn * __builtin_amdgcn_sinf(f);
    const float r2 = __builtin_fmaf(re, c, -(im * sn)), i2 = __builtin_fmaf(re, sn, im * c); re = r2; im = i2;
}
constexpr int FTAB = 131072;
__device__ __forceinline__ bf16x8 tab_frag(Frame& F, int id) { return *(const LAS bf16x8*)(F.lds + FTAB + (id * 64 + F.lane) * 16); }
__device__ __forceinline__ void fft_build_table(Frame& F) {
    const int idx = F.lane & 15, g = F.lane >> 4;
    for (int id = 2 * F.wave; id < 2 * F.wave + 2; ++id) { bf16x8 v;
        if (id < 2) v = dft_frag(16, -1.f, 0, idx, g, id & 1);
        else if (id < 4) v = dft_frag(16, 1.f, 0, idx, g, id & 1);
        else if (id < 8) v = dft_frag(32, -1.f, 0, 16 * ((id >> 1) & 1) + idx, g, id & 1);
        else if (id < 12) v = dft_frag(32, 1.f, 16 * (id & 1), idx, g, (id >> 1) & 1);
        else v = dft_frag(32, -1.f, 16, 16 * ((id >> 1) & 1) + idx, g, id & 1);
        *(LAS bf16x8*)(F.lds + FTAB + (id * 64 + F.lane) * 16) = v; }
}
__device__ __forceinline__ void twid4(float (&re)[4], float (&im)[4], int base, int step, int den_mask, float den_inv, float sgn) {
    const float fb = (float)(base & den_mask) * den_inv, fs = (float)(step & den_mask) * den_inv;
    float c = __builtin_amdgcn_cosf(fb), sn = sgn * __builtin_amdgcn_sinf(fb);
    const float cs = __builtin_amdgcn_cosf(fs), ss = sgn * __builtin_amdgcn_sinf(fs);
#pragma unroll
    for (int r = 0; r < 4; ++r) {
        const float r2 = __builtin_fmaf(re[r], c, -(im[r] * sn)), i2 = __builtin_fmaf(re[r], sn, im[r] * c); re[r] = r2; im[r] = i2;
        if (r < 3) { const float c2 = __builtin_fmaf(c, cs, -(sn * ss)), s2 = __builtin_fmaf(c, ss, sn * cs); c = c2; sn = s2; } }
}
template <int NA>
__device__ __forceinline__ void fft_s1(Frame& F, LAS unsigned char* inre, LAS unsigned char* inim, bool imzero) {
    const int lane = F.lane, idx = lane & 15, g = lane >> 4; LAS unsigned char* W = F.lds + FW;
    bf16x8 B[2][2][NA];
#pragma unroll
    for (int hi = 0; hi < 2; ++hi)
#pragma unroll
        for (int part = 0; part < 2; ++part)
#pragma unroll
            for (int sa = 0; sa < NA; ++sa) B[hi][part][sa] = tab_frag(F, (sa ? 12 : 4) + 2 * hi + part);
#pragma unroll
    for (int tq = 0; tq < 2; ++tq) { const int tc = 2 * F.wave + tq;
        bf16x8 A[NA];
#pragma unroll
        for (int sa = 0; sa < NA; ++sa) { const int eo = ((tc * 16 + idx) * (16 * NA)) + 16 * sa + 8 * (g & 1);
            u32x4 z = (u32x4){0u, 0u, 0u, 0u};
            if (g < 2) z = *(const LAS u32x4*)(inre + fsw(eo * 2)); else if (!imzero) z = *(const LAS u32x4*)(inim + fsw(eo * 2));
            A[sa] = __builtin_bit_cast(bf16x8, z); }
#pragma unroll
        for (int hi = 0; hi < 2; ++hi) { facc cr = (facc){0.f, 0.f, 0.f, 0.f}, ci = cr;
#pragma unroll
            for (int sa = 0; sa < NA; ++sa) { cr = fmma_acc(A[sa], B[hi][0][sa], cr); ci = fmma_acc(A[sa], B[hi][1][sa], ci); }
            const int ka = 16 * hi + idx; float re[4], im[4];
#pragma unroll
            for (int r = 0; r < 4; ++r) { re[r] = cr[r]; im[r] = ci[r]; }
            twid4(re, im, 4 * g * ka, ka, 511, 1.0f / 512.0f, -1.f);
            st_quad(W, (ka * 16 + tc) * 16 + 4 * g, re, im); }
    }
}
__device__ __forceinline__ void fft_s2(Frame& F) {
    const int lane = F.lane, idx = lane & 15, g = lane >> 4; LAS unsigned char* W = F.lds + FW;
    const bf16x8 Br = tab_frag(F, 0), Bi = tab_frag(F, 1);
#pragma unroll 2
    for (int kq = 0; kq < 4; ++kq) { const int ka = 4 * F.wave + kq;
        const bf16x8 A = ld_frag(W, (ka * 16 + idx) * 16, g);
        const facc cr = fmma(A, Br), ci = fmma(A, Bi);
        float re[4], im[4];
#pragma unroll
        for (int r = 0; r < 4; ++r) { re[r] = cr[r]; im[r] = ci[r]; }
            twid4(re, im, 4 * g * (ka + 32 * idx), ka + 32 * idx, 8191, 1.0f / 8192.0f, -1.f);
        st_quad(W, (ka * 16 + idx) * 16 + 4 * g, re, im);
    }
}
template <int MODE>
__device__ __forceinline__ void fft_s3(Frame& F, unsigned* KH) {
    const int lane = F.lane, idx = lane & 15, g = lane >> 4; LAS unsigned char* W = F.lds + FW;
    const bf16x8 Ar = tab_frag(F, 0), Ai = tab_frag(F, 1);
#pragma unroll 2
    for (int kq = 0; kq < 4; ++kq) { const int ka = 4 * F.wave + kq;
        const bf16x8 Bd = ld_frag(W, (ka * 16 + idx) * 16, g);
        const facc cr = fmma(Ar, Bd), ci = fmma(Ai, Bd);
        const int eo = (ka * 16 + idx) * 16 + 4 * g;
        if (MODE == 1) { u32x4 o; o.x = pk2(cr[0], ci[0]); o.y = pk2(cr[1], ci[1]); o.z = pk2(cr[2], ci[2]); o.w = pk2(cr[3], ci[3]); *(u32x4*)(KH + eo) = o; }
        else { const u32x4 kv = *(const u32x4*)(KH + eo); const unsigned kw[4] = {kv.x, kv.y, kv.z, kv.w}; float re[4], im[4];
#pragma unroll
            for (int r = 0; r < 4; ++r) { const float kr = bflo(kw[r]), ki = bfhi(kw[r]); re[r] = __builtin_fmaf(cr[r], kr, -(ci[r] * ki)); im[r] = __builtin_fmaf(cr[r], ki, ci[r] * kr); }
            st_quad(W, eo, re, im); }
    }
}
__device__ __forceinline__ void fft_i1(Frame& F) {
    const int lane = F.lane, idx = lane & 15, g = lane >> 4; LAS unsigned char* W = F.lds + FW;
    const bf16x8 Br = tab_frag(F, 2), Bi = tab_frag(F, 3);
#pragma unroll 2
    for (int kq = 0; kq < 4; ++kq) { const int ka = 4 * F.wave + kq;
        const bf16x8 A = ld_frag(W, (ka * 16 + idx) * 16, g);
        const facc cr = fmma(A, Br), ci = fmma(A, Bi);
        float re[4], im[4];
#pragma unroll
        for (int r = 0; r < 4; ++r) { re[r] = cr[r]; im[r] = ci[r]; }
            twid4(re, im, idx * (ka + 128 * g), 32 * idx, 8191, 1.0f / 8192.0f, 1.f);
        st_quad(W, (ka * 16 + idx) * 16 + 4 * g, re, im);
    }
}
__device__ __forceinline__ void fft_mid(Frame& F, const u32x4 (&kvq)[4]) {
    const int lane = F.lane, idx = lane & 15, g = lane >> 4; LAS unsigned char* W = F.lds + FW;
    const bf16x8 Fr = tab_frag(F, 0), Fi = tab_frag(F, 1), Gr = tab_frag(F, 2), Gi = tab_frag(F, 3);
#pragma unroll 1
    for (int kp = 0; kp < 2; ++kp) {
        const int ka0 = 4 * F.wave + 2 * kp, eb0 = (ka0 * 16 + idx) * 16, eb1 = eb0 + 256, eo0 = eb0 + 4 * g, eo1 = eb1 + 4 * g;
        const u32x4 kv0 = kp ? kvq[2] : kvq[0], kv1 = kp ? kvq[3] : kvq[1];
        float re[4], im[4];
        {
            const bf16x8 A0 = ld_frag(W, eb0, g), A1 = ld_frag(W, eb1, g);
            const facc cr0 = fmma(A0, Fr), ci0 = fmma(A0, Fi), cr1 = fmma(A1, Fr), ci1 = fmma(A1, Fi);
            __builtin_amdgcn_sched_barrier(0);
#pragma unroll
            for (int r = 0; r < 4; ++r) { re[r] = cr0[r]; im[r] = ci0[r]; }
            twid4(re, im, 4 * g * (ka0 + 32 * idx), ka0 + 32 * idx, 8191, 1.0f / 8192.0f, -1.f); st_quad(W, eo0, re, im);
#pragma unroll
            for (int r = 0; r < 4; ++r) { re[r] = cr1[r]; im[r] = ci1[r]; }
            twid4(re, im, 4 * g * (ka0 + 1 + 32 * idx), ka0 + 1 + 32 * idx, 8191, 1.0f / 8192.0f, -1.f); st_quad(W, eo1, re, im); }
        LDS_ORDER();
        {
            const bf16x8 B0 = ld_frag(W, eb0, g), B1 = ld_frag(W, eb1, g);
            const facc cr0 = fmma(Fr, B0), ci0 = fmma(Fi, B0), cr1 = fmma(Fr, B1), ci1 = fmma(Fi, B1);
            __builtin_amdgcn_sched_barrier(0);
            const unsigned kw0[4] = {kv0.x, kv0.y, kv0.z, kv0.w}, kw1[4] = {kv1.x, kv1.y, kv1.z, kv1.w};
#pragma unroll
            for (int r = 0; r < 4; ++r) { const float kr = bflo(kw0[r]), ki = bfhi(kw0[r]); re[r] = __builtin_fmaf(cr0[r], kr, -(ci0[r] * ki)); im[r] = __builtin_fmaf(cr0[r], ki, ci0[r] * kr); }
            st_quad(W, eo0, re, im);
#pragma unroll
            for (int r = 0; r < 4; ++r) { const float kr = bflo(kw1[r]), ki = bfhi(kw1[r]); re[r] = __builtin_fmaf(cr1[r], kr, -(ci1[r] * ki)); im[r] = __builtin_fmaf(cr1[r], ki, ci1[r] * kr); }
            st_quad(W, eo1, re, im); }
        LDS_ORDER();
        {
            const bf16x8 A0 = ld_frag(W, eb0, g), A1 = ld_frag(W, eb1, g);
            const facc cr0 = fmma(A0, Gr), ci0 = fmma(A0, Gi), cr1 = fmma(A1, Gr), ci1 = fmma(A1, Gi);
            __builtin_amdgcn_sched_barrier(0);
#pragma unroll
            for (int r = 0; r < 4; ++r) { re[r] = cr0[r]; im[r] = ci0[r]; }
            twid4(re, im, idx * (ka0 + 128 * g), 32 * idx, 8191, 1.0f / 8192.0f, 1.f); st_quad(W, eo0, re, im);
#pragma unroll
            for (int r = 0; r < 4; ++r) { re[r] = cr1[r]; im[r] = ci1[r]; }
            twid4(re, im, idx * (ka0 + 1 + 128 * g), 32 * idx, 8191, 1.0f / 8192.0f, 1.f); st_quad(W, eo1, re, im); }
        LDS_ORDER();
    }
}
__device__ __forceinline__ void fft_i2(Frame& F) {
    const int lane = F.lane, idx = lane & 15, g = lane >> 4; LAS unsigned char* W = F.lds + FW; LAS unsigned char* W2 = F.lds + FW2;
    const bf16x8 Br = tab_frag(F, 2), Bi = tab_frag(F, 3);
#pragma unroll 1
    for (int tq = 0; tq < 4; ++tq) { const int t = 4 * F.wave + tq, c = t >> 1, hi = t & 1;
        const bf16x8 A = ld_frag(W, ((16 * hi + idx) * 16 + c) * 16, g);
        const facc cr = fmma(A, Br), ci = fmma(A, Bi);
        float re[4], im[4];
#pragma unroll
        for (int r = 0; r < 4; ++r) { re[r] = cr[r]; im[r] = ci[r]; }
        twid4(re, im, idx * (16 * hi + 4 * g), idx, 511, 1.0f / 512.0f, 1.f);
        st_quad(W2, (c * 16 + idx) * 32 + 16 * hi + 4 * g, re, im);
    }
}
__device__ __forceinline__ void fft_i3_tile(Frame& F, int b, const bf16x8 (&B)[2][2], float (&yre)[4], float (&yim)[4]) {
    const int lane = F.lane, idx = lane & 15, g = lane >> 4; LAS unsigned char* W2 = F.lds + FW2;
    facc cr = (facc){0.f, 0.f, 0.f, 0.f}, ci = cr;
#pragma unroll
    for (int sa = 0; sa < 2; ++sa) { const bf16x8 A = ld_frag(W2, (idx * 16 + b) * 32 + 16 * sa, g); cr = fmma_acc(A, B[0][sa], cr); ci = fmma_acc(A, B[1][sa], ci); }
#pragma unroll
    for (int r = 0; r < 4; ++r) { yre[r] = cr[r] * (1.0f / 8192.0f); yim[r] = ci[r] * (1.0f / 8192.0f); }
}
__device__ __forceinline__ void fft_load_kernel(Frame& F, int order, int ch) {
    const bf16_t* hf = (const bf16_t*)(F.ws + WS_FG) + ((size_t)((order * 2 + 0) * 1024 + ch)) * 4096;
    const bf16_t* hb = (const bf16_t*)(F.ws + WS_FG) + ((size_t)((order * 2 + 1) * 1024 + ch)) * 4096;
    LAS bf16_t* K = (LAS bf16_t*)(F.lds + FW2);
    const int t0 = 8 * F.tid; const u32x4 vf = *(const u32x4*)(hf + t0), vb = *(const u32x4*)(hb + t0);
    const unsigned wf[4] = {vf.x, vf.y, vf.z, vf.w}, wb[4] = {vb.x, vb.y, vb.z, vb.w};
#pragma unroll
    for (int e = 0; e < 8; ++e) { const int t = t0 + e; const unsigned f = (wf[e >> 1] >> (16 * (e & 1))) & 0xffffu, bk = (wb[e >> 1] >> (16 * (e & 1))) & 0xffffu;
        { const int m = t; *(LAS bf16_t*)((LAS unsigned char*)K + fsw(((((m & 15) * 16 + ((m >> 4) & 15)) * 32) + (m >> 8)) * 2)) = (bf16_t)f; }
        { const int m = (8192 - t) & 8191; const unsigned v = t == 0 ? f : bk; if (t != 0) *(LAS bf16_t*)((LAS unsigned char*)K + fsw(((((m & 15) * 16 + ((m >> 4) & 15)) * 32) + (m >> 8)) * 2)) = (bf16_t)v; } }
    if (F.tid == 0) { const int m = 4096; *(LAS bf16_t*)((LAS unsigned char*)K + fsw(((((m & 15) * 16 + ((m >> 4) & 15)) * 32) + (m >> 8)) * 2)) = (bf16_t)0; }
}
__device__ __forceinline__ void fft_commit_u(Frame& F, int c, const HyU& r) {
    const float w0 = F.in[I_CBW][0 * 3072 + c], w1 = F.in[I_CBW][1 * 3072 + c], w2 = F.in[I_CBW][2 * 3072 + c], bb = F.in[I_CBB][c];
    const int s0 = 8 * F.tid, a = s0 >> 8, b4 = (s0 >> 4) & 15, c0 = s0 & 15;
#pragma unroll
    for (int b = 0; b < NB; ++b) {
        float x[10]; x[0] = bf2f(r.pvb[b]); x[1] = bflo(r.mv[b].x); x[2] = bfhi(r.mv[b].x); x[3] = bflo(r.mv[b].y); x[4] = bfhi(r.mv[b].y); x[5] = bflo(r.mv[b].z); x[6] = bfhi(r.mv[b].z); x[7] = bflo(r.mv[b].w); x[8] = bfhi(r.mv[b].w); x[9] = bf2f(r.nvb[b]);
        LAS bf16_t* row = (LAS bf16_t*)(F.lds + FU + b * 8192);
#pragma unroll
        for (int e = 0; e < 8; e += 2) { const unsigned zz = cvt_pk_bf16(bb + w0 * x[e] + w1 * x[e + 1] + w2 * x[e + 2], bb + w0 * x[e + 1] + w1 * x[e + 2] + w2 * x[e + 3]);
            *(LAS bf16_t*)((LAS unsigned char*)row + fsw((((c0 + e) * 16 + b4) * 16 + a) * 2)) = (bf16_t)zz; *(LAS bf16_t*)((LAS unsigned char*)row + fsw((((c0 + e + 1) * 16 + b4) * 16 + a) * 2)) = (bf16_t)(zz >> 16); }
    }
}
struct GateRaw { u32x2 mv; bf16_t pv, nv; };
__device__ __forceinline__ void fft_gate_load(Frame& F, int part, int batch, int c, int t, GateRaw& q) {
    const bf16_t* src = (const bf16_t*)(F.ws + WS_HYT) + ((size_t)((part * NB + batch) * DM + c)) * SEQ;
    q.mv = *(const u32x2*)(src + t); q.pv = src[t > 0 ? t - 1 : 0]; q.nv = src[(t + 4 < SEQ) ? t + 4 : SEQ - 1];
}
__device__ __forceinline__ void fft_gate_eval(const GateRaw& q, int t, float w0, float w1, float w2, float bb, float (&gq)[4]) {
    const float pv = t > 0 ? bf2f(q.pv) : 0.f, nv = (t + 4 < SEQ) ? bf2f(q.nv) : 0.f;
    const float x[6] = {pv, bflo(q.mv.x), bfhi(q.mv.x), bflo(q.mv.y), bfhi(q.mv.y), nv};
#pragma unroll
    for (int e = 0; e < 4; ++e) gq[e] = bb + w0 * x[e] + w1 * x[e + 1] + w2 * x[e + 2];
}
__device__ __forceinline__ void hyena_channel_fft(Frame& F, int c, int it, int cnext, bf16_t* UBT, HyU& pu) {
    const int lane = F.lane, idx = lane & 15, g = lane >> 4;
    unsigned* KHbase = (unsigned*)(F.ws + 456 * MiB) + ((size_t)blockIdx.x * 8 + it * 2) * 8192;
    __syncthreads();
    { HyU pr; hy_fetch_u_now(F, 0, c, pr); fft_commit_u(F, c, pr); }
    if (cnext >= 0) hy_touch_u(F, 0, cnext, F.lds + FTAB + 16384);
    bf16x8 B3[2][2];
#pragma unroll
    for (int part = 0; part < 2; ++part)
#pragma unroll
        for (int sa = 0; sa < 2; ++sa) B3[part][sa] = tab_frag(F, 8 + 2 * part + sa);
    for (int order = 0; order < 2; ++order) {
        unsigned* KH = KHbase + order * 8192;
        const int gp = 1 + order;
        const float w0 = F.in[I_CBW][0 * 3072 + gp * 1024 + c], w1 = F.in[I_CBW][1 * 3072 + gp * 1024 + c], w2 = F.in[I_CBW][2 * 3072 + gp * 1024 + c], bb = F.in[I_CBB][gp * 1024 + c];
        __syncthreads();
        fft_load_kernel(F, order, c);
        LDS_WAIT(); __syncthreads();
        fft_s1<2>(F, F.lds + FW2, F.lds + FW2, true);
        LDS_WAIT(); __syncthreads();
        fft_s2(F);
        LDS_WAIT(); __syncthreads();
        fft_s3<1>(F, KH);
        VM_WAIT(); __syncthreads();
        u32x4 kvq[4];
#pragma unroll
        for (int q = 0; q < 4; ++q) kvq[q] = *(const u32x4*)(KH + ((4 * F.wave + q) * 16 + idx) * 16 + 4 * g);
        for (int p = 0; p < 4; ++p) {
            GateRaw gq[2][2];
#pragma unroll
            for (int bq = 0; bq < 2; ++bq) { const int t = 256 * idx + 16 * (2 * F.wave + bq) + 4 * g; fft_gate_load(F, gp, 2 * p, c, t, gq[bq][0]); fft_gate_load(F, gp, 2 * p + 1, c, t, gq[bq][1]); }
            __builtin_amdgcn_sched_barrier(0);
            fft_s1<1>(F, F.lds + FU + (2 * p) * 8192, F.lds + FU + (2 * p + 1) * 8192, false);
            LDS_WAIT(); __syncthreads();
            fft_mid(F, kvq);
            LDS_WAIT(); __syncthreads();
            fft_i2(F);
            LDS_WAIT(); __syncthreads();
#pragma unroll
            for (int bq = 0; bq < 2; ++bq) { const int b = 2 * F.wave + bq;
                float yre[4], yim[4], g0[4], g1[4];
                const int t = 256 * idx + 16 * b + 4 * g;
                fft_i3_tile(F, b, B3, yre, yim);
                fft_gate_eval(gq[bq][0], t, w0, w1, w2, bb, g0); fft_gate_eval(gq[bq][1], t, w0, w1, w2, bb, g1);
                if (order == 0) {
                    LAS bf16_t* r0 = (LAS bf16_t*)(F.lds + FU + (2 * p) * 8192); LAS bf16_t* r1 = (LAS bf16_t*)(F.lds + FU + (2 * p + 1) * 8192);
#pragma unroll
                    for (int r = 0; r < 4; ++r) { const int eo = ((4 * g + r) * 16 + b) * 16 + idx; const unsigned zz = cvt_pk_bf16(g0[r] * yre[r], g1[r] * yim[r]); *(LAS bf16_t*)((LAS unsigned char*)r0 + fsw(eo * 2)) = (bf16_t)zz; *(LAS bf16_t*)((LAS unsigned char*)r1 + fsw(eo * 2)) = (bf16_t)(zz >> 16); }
                } else {
                    *(u32x2*)(UBT + ((size_t)((2 * p) * DM + c)) * SEQ + t) = (u32x2){cvt_pk_bf16(g0[0] * yre[0], g0[1] * yre[1]), cvt_pk_bf16(g0[2] * yre[2], g0[3] * yre[3])};
                    *(u32x2*)(UBT + ((size_t)((2 * p + 1) * DM + c)) * SEQ + t) = (u32x2){cvt_pk_bf16(g1[0] * yim[0], g1[1] * yim[1]), cvt_pk_bf16(g1[2] * yim[2], g1[3] * yim[3])};
                }
            }
            LDS_WAIT(); __syncthreads();
        }
    }
}
__device__ __forceinline__ void hyena_phase_fft(Frame& F, bf16_t* UBT) {
    __syncthreads();
    fft_build_table(F);
    LDS_WAIT(); __syncthreads();
    HyU pu;
    int it = 0;
    for (int c = F.vcu; c < DM; c += F.G, ++it) hyena_channel_fft(F, c, it & 3, (c + F.G < DM) ? c + F.G : -1, UBT, pu);
    __syncthreads();
}
__device__ __forceinline__ void ub_transpose_item(Frame& F, int it, LAS bf16_t* tile) {
    const bf16_t* UBT = (const bf16_t*)(F.ws + WS_HYT); bf16_t* UB = (bf16_t*)(F.ws + WS_HYT + 64 * MiB);
    const int lane = F.lane;
    const int b = it >> 10, cb = (it >> 6) & 15, sb = it & 63, c0 = cb * 64, s0 = sb * 64;
#pragma unroll
    for (int i = 0; i < 8; ++i) { const int cl = i * 8 + (lane >> 3), pp = lane & 7;
        const u32x4 v = *(const u32x4*)(UBT + ((size_t)(b * DM + c0 + cl)) * SEQ + s0 + 8 * pp);
        const unsigned wv[4] = {v.x, v.y, v.z, v.w};
#pragma unroll
        for (int e = 0; e < 8; ++e) tile[(8 * pp + e) * 66 + cl] = (bf16_t)((wv[e >> 1] >> (16 * (e & 1))) & 0xffffu); }
    LDS_WAIT();
#pragma unroll
    for (int i = 0; i < 8; ++i) { const int sl = i * 8 + (lane >> 3), pp = lane & 7;
        const LAS unsigned* src = (const LAS unsigned*)(tile + sl * 66 + 8 * pp);
        u32x4 v; v.x = src[0]; v.y = src[1]; v.z = src[2]; v.w = src[3];
        *(u32x4*)(UB + ((size_t)(b * SEQ + s0 + sl)) * DM + c0 + 8 * pp) = v; }
    LDS_WAIT();
}
__device__ __forceinline__ void ub_transpose_phase(Frame& F, int tdone) {
    LAS bf16_t* tile = (LAS bf16_t*)(F.lds + F.wave * 16384);
    const int gw = F.vcu * NWAVES + F.wave, NGW = F.G * NWAVES;
    for (int it = gw + tdone * NGW; it < NB * 16 * 64; it += NGW) ub_transpose_item(F, it, tile);
}

__device__ __forceinline__ void topk_wave(Frame& F, int b, int e);
constexpr int RT_WR = 0, RT_SCR = 65536;
__device__ __forceinline__ void router_row(Frame& F, int m, const float (&gf)[16], const u32x2 (&vin)[4]) {
    const LAS float* wrT = (const LAS float*)(F.lds + RT_WR);
    f32x4 v[4]; float s = 0.f;
#pragma unroll
    for (int j = 0; j < 4; ++j) { v[j] = bf4(vin[j]); s += (v[j].x * v[j].x + v[j].y * v[j].y) + (v[j].z * v[j].z + v[j].w * v[j].w); }
    s = wave_sum(s);
    const float rstd = 1.0f / sqrtf(s * (1.0f / DM) + EPS);
    unsigned* o4 = (unsigned*)(F.ws + WS_H2 + (size_t)m * DM) + F.lane;
#pragma unroll
    for (int j = 0; j < 4; ++j) { v[j].x *= rstd * gf[4 * j + 0]; v[j].y *= rstd * gf[4 * j + 1]; v[j].z *= rstd * gf[4 * j + 2]; v[j].w *= rstd * gf[4 * j + 3];
        o4[64 * j] = pk4_fp8(fp8_clamp(v[j].x), fp8_clamp(v[j].y), fp8_clamp(v[j].z), fp8_clamp(v[j].w)); }
    float acc[16];
#pragma unroll
    for (int e = 0; e < 16; ++e) { float a = 0.f;
#pragma unroll
        for (int j = 0; j < 4; ++j) { const f32x4 wv = *(const LAS f32x4*)(wrT + e * 1024 + 256 * j + 4 * F.lane); a += (v[j].x * wv.x + v[j].y * wv.y) + (v[j].z * wv.z + v[j].w * wv.w); }
        acc[e] = a; if ((e & 3) == 3) asm volatile("" ::: "memory"); }
    const int lane = F.lane; float r8[8], r4[4], r2[2], lgt;
    { const bool up = (lane & 32) != 0;
#pragma unroll
      for (int i = 0; i < 8; ++i) { const float keep = up ? acc[i + 8] : acc[i], send = up ? acc[i] : acc[i + 8]; r8[i] = keep + __shfl_xor(send, 32); } }
    { const bool up = (lane & 16) != 0;
#pragma unroll
      for (int i = 0; i < 4; ++i) { const float keep = up ? r8[i + 4] : r8[i], send = up ? r8[i] : r8[i + 4]; r4[i] = keep + __shfl_xor(send, 16); } }
    { const bool up = (lane & 8) != 0;
#pragma unroll
      for (int i = 0; i < 2; ++i) { const float keep = up ? r4[i + 2] : r4[i], send = up ? r4[i] : r4[i + 2]; r2[i] = keep + __shfl_xor(send, 8); } }
    { const bool up = (lane & 4) != 0; const float keep = up ? r2[1] : r2[0], send = up ? r2[0] : r2[1]; lgt = keep + __shfl_xor(send, 4); }
    lgt += __shfl_xor(lgt, 2); lgt += __shfl_xor(lgt, 1);
    float mx = lgt;
#pragma unroll
    for (int o = 4; o < 64; o <<= 1) mx = fmaxf(mx, __shfl_xor(mx, o));
    const float p = expf(lgt - mx); float den = p;
#pragma unroll
    for (int o = 4; o < 64; o <<= 1) den += __shfl_xor(den, o);
    if ((lane & 3) == 0) { const int ex = ((lane >> 5) & 1) * 8 + ((lane >> 4) & 1) * 4 + ((lane >> 3) & 1) * 2 + ((lane >> 2) & 1);
        const int b = m >> 12, sq = m & 4095; ((float*)(F.ws + WS_AFF))[(size_t)(b * 16 + ex) * SEQ + sq] = p / den; }
}
__device__ __forceinline__ void phase6(Frame& F) {
    LAS float* wrT = (LAS float*)(F.lds + RT_WR);
    __syncthreads();
    for (int idx = F.tid; idx < 16384; idx += NTHREADS) wrT[(idx & 15) * 1024 + (idx >> 4)] = F.in[I_WROUTER][idx];
    LDS_WAIT(); __syncthreads();
    float gf[16];
#pragma unroll
    for (int j = 0; j < 4; ++j) { const f32x4 g4 = *((const f32x4*)F.in[I_GFFN] + 64 * j + F.lane); gf[4 * j] = g4.x; gf[4 * j + 1] = g4.y; gf[4 * j + 2] = g4.z; gf[4 * j + 3] = g4.w; }
#pragma unroll
    for (int j = 0; j < 16; ++j) asm volatile("" : "+v"(gf[j]));
    const int gw = F.vcu * NWAVES + F.wave, NGW = F.G * NWAVES;
    constexpr int I_GU = (DM / 128) * (DFF / 32), I_DN = (DFF / 128) * (DM / 32), I_ALL = NEXP * (2 * I_GU + I_DN);
    const bool tk = (gw & 15) == 0; const int cw = gw - (gw >> 4) - 1, NCW = NGW - (NGW >> 4);
    int it0 = tk ? (1 << 30) : cw;
#define P6_DECODE(q, it0_) do { const int it_ = REPS(13) > 1 ? (it0_) % I_ALL : (it0_); const int e_ = it_ / (2 * I_GU + I_DN); int r_ = it_ % (2 * I_GU + I_DN); \
        if (r_ < I_GU) { q.W = F.in[I_WGATE] + (size_t)e_ * DM * DFF; q.K = DM; q.N = DFF; q.WT = F.ws + WS_WGU + (size_t)e_ * 4096 * DM; q.mode = 1; q.off = 0; q.item = r_; } \
        else if (r_ < 2 * I_GU) { q.W = F.in[I_WUP] + (size_t)e_ * DM * DFF; q.K = DM; q.N = DFF; q.WT = F.ws + WS_WGU + (size_t)e_ * 4096 * DM; q.mode = 1; q.off = 128; q.item = r_ - I_GU; } \
        else { q.W = F.in[I_WDOWN] + (size_t)e_ * DFF * DM; q.K = DFF; q.N = DM; q.WT = F.ws + WS_WD + (size_t)e_ * DM * DFF; q.mode = 0; q.off = 0; q.item = r_ - 2 * I_GU; } } while (0)
    { u32x2 cur[4], nxt[4]; const bf16_t* XM = (const bf16_t*)(F.ws + WS_XMID);
      if (gw < NT) row_load_bf(XM, gw, F.lane, cur);
      for (int m = gw; m < NT; m += NGW) {
#pragma unroll
          for (int j = 0; j < 4; ++j) nxt[j] = cur[j];
          if (m + NGW < NT) row_load_bf(XM, m + NGW, F.lane, nxt);
          const bool has = it0 < I_ALL * REPS(13) && (((m - gw) / NGW) & 1) == 0;
          F8Item q; f32x4 wv[16];
          if (has) { P6_DECODE(q, it0); f8_issue(q, F.lane, wv); }
          router_row(F, m, gf, cur);
          if (has) { f8_finish(q, F.lane, wv); it0 += NCW; }
#pragma unroll
          for (int j = 0; j < 4; ++j) cur[j] = nxt[j]; } }
    unsigned* rows_done = (unsigned*)(F.ws + WS_CTL) + 8192;
    VM_WAIT(); __syncthreads();
    if (F.tid == 0) { __builtin_amdgcn_fence(__ATOMIC_RELEASE, "agent"); asm volatile("s_waitcnt vmcnt(0)" ::: "memory"); (void)__hip_atomic_fetch_add(rows_done, 1u, __ATOMIC_RELAXED, __HIP_MEMORY_SCOPE_AGENT); }
    for (; it0 < I_ALL * REPS(13); it0 += NCW) { F8Item q; f32x4 wv[16]; P6_DECODE(q, it0); f8_issue(q, F.lane, wv); f8_finish(q, F.lane, wv); }
#undef P6_DECODE
    if ((gw & 15) == 0) {
        unsigned sp = 0; unsigned* tmo = (unsigned*)(F.ws + WS_CTL) + 4096 + XB_TMO;
        while ((unsigned)__builtin_amdgcn_readfirstlane((int)__hip_atomic_load(rows_done, __ATOMIC_RELAXED, __HIP_MEMORY_SCOPE_AGENT)) < (unsigned)F.G) {
            __builtin_amdgcn_s_sleep(2); if (++sp > XB_SPIN_CAP) { if (F.lane == 0) atomicAdd(tmo, 1u); break; } }
        __builtin_amdgcn_fence(__ATOMIC_ACQUIRE, "agent"); asm volatile("s_waitcnt vmcnt(0)" ::: "memory");
        for (int p = gw >> 4; p < NB * NEXP; p += NGW >> 4) topk_wave(F, p >> 4, p & 15);
    }
    __syncthreads();
}
__device__ __forceinline__ int block_excl_scan(Frame& F, int x, LAS int* red, int* tot) {
    int inc = x;
#pragma unroll
    for (int o = 1; o < 64; o <<= 1) { const int y = __shfl_up(inc, o); if (F.lane >= o) inc += y; }
    __syncthreads();
    if (F.lane == 63) red[F.wave] = inc;
    LDS_WAIT(); __syncthreads();
    int base = 0, t = 0;
#pragma unroll
    for (int wv = 0; wv < NWAVES; ++wv) { const int c = red[wv]; if (wv < F.wave) base += c; t += c; }
    *tot = t;
    return base + inc - x;
}
__device__ __forceinline__ void topk_block(Frame& F, int b, int e) {
    LAS int* red = (LAS int*)(F.lds);
    const float* aff = (const float*)(F.ws + WS_AFF) + (size_t)(b * 16 + e) * SEQ + 8 * F.tid;
    const f32x4 v0 = *(const f32x4*)aff, v1 = *(const f32x4*)(aff + 4);
    const float v[8] = {v0.x, v0.y, v0.z, v0.w, v1.x, v1.y, v1.z, v1.w};
    unsigned u[8];
#pragma unroll
    for (int i = 0; i < 8; ++i) u[i] = __builtin_bit_cast(unsigned, v[i]);
    unsigned prefix = 0;
    __syncthreads();
    for (int bit = 30; bit >= 0; --bit) {
        const unsigned cand = prefix | (1u << bit); int cnt = 0;
#pragma unroll
        for (int i = 0; i < 8; ++i) cnt += (u[i] >= cand) ? 1 : 0;
#pragma unroll
        for (int o = 1; o < 64; o <<= 1) cnt += __shfl_xor(cnt, o);
        if (F.lane == 0) red[(bit & 1) * 8 + F.wave] = cnt;
        LDS_WAIT(); __syncthreads();
        int tot = 0;
#pragma unroll
        for (int wv = 0; wv < NWAVES; ++wv) tot += red[(bit & 1) * 8 + wv];
        if (tot >= CAP) prefix = cand;
    }
    const unsigned T = prefix;
    int ngt = 0, neq = 0;
#pragma unroll
    for (int i = 0; i < 8; ++i) { ngt += (u[i] > T) ? 1 : 0; neq += (u[i] == T) ? 1 : 0; }
    int tot_gt = 0, tot_eq = 0;
    (void)block_excl_scan(F, ngt, red + 32, &tot_gt);
    int eqr = block_excl_scan(F, neq, red + 48, &tot_eq);
    const int need = CAP - tot_gt;
    bool sel[8]; int nsel = 0;
#pragma unroll
    for (int i = 0; i < 8; ++i) { bool sl = u[i] > T; if (u[i] == T) { sl = eqr < need; ++eqr; } sel[i] = sl; nsel += sl ? 1 : 0; }
    int tot_sel = 0;
    int slot = block_excl_scan(F, nsel, red + 64, &tot_sel);
    int* TOK = (int*)(F.ws + WS_TOK); float* VAL = (float*)(F.ws + WS_VAL); bf16_t* SLOT = (bf16_t*)(F.ws + WS_SLOT);
#pragma unroll
    for (int i = 0; i < 8; ++i) { const int sq = 8 * F.tid + i; unsigned short so = 0xFFFFu;
        if (sel[i]) { TOK[e * 4096 + b * CAP + slot] = b * SEQ + sq; VAL[e * 4096 + b * CAP + slot] = v[i]; so = (unsigned short)slot; ++slot; }
        SLOT[(size_t)(b * SEQ + sq) * 16 + e] = so; }
    __syncthreads();
}
__device__ __forceinline__ int wave_sum_i(int v) {
#pragma unroll
    for (int o = 1; o < 64; o <<= 1) v += __shfl_xor(v, o);
    return v;
}
__device__ __forceinline__ int wave_excl_scan_i(int x, int lane, int* tot) {
    int inc = x;
#pragma unroll
    for (int o = 1; o < 64; o <<= 1) { const int y = __shfl_up(inc, o); if (lane >= o) inc += y; }
    *tot = __shfl(inc, 63);
    return inc - x;
}
__device__ __forceinline__ void topk_wave(Frame& F, int b, int e) {
    const int lane = F.lane;
    const float* aff = (const float*)(F.ws + WS_AFF) + (size_t)(b * 16 + e) * SEQ + 64 * lane;
    unsigned u[64];
#pragma unroll
    for (int q = 0; q < 16; ++q) { const f32x4 v = *(const f32x4*)(aff + 4 * q); const float a0 = v.x, a1 = v.y, a2 = v.z, a3 = v.w;
        u[4 * q] = __float_as_uint(a0); u[4 * q + 1] = __float_as_uint(a1); u[4 * q + 2] = __float_as_uint(a2); u[4 * q + 3] = __float_as_uint(a3); }
    unsigned prefix = 0;
    for (int bit = 30; bit >= 0; --bit) { const unsigned cand = prefix | (1u << bit); int cnt = 0;
#pragma unroll
        for (int i = 0; i < 64; ++i) cnt += (int)((cand - 1u - u[i]) >> 31);
        if (wave_sum_i(cnt) >= CAP) prefix = cand; }
    const unsigned T = prefix; int ngt = 0, nge = 0;
#pragma unroll
    for (int i = 0; i < 64; ++i) { ngt += (int)((T - u[i]) >> 31); nge += (int)((T - 1u - u[i]) >> 31); }
    const int neq = nge - ngt;
    int tot_gt, tot_eq, tot_sel;
    (void)wave_excl_scan_i(ngt, lane, &tot_gt);
    int eqr = wave_excl_scan_i(neq, lane, &tot_eq);
    const int need = CAP - tot_gt;
    int nsel = 0; { int er = eqr;
#pragma unroll
        for (int i = 0; i < 64; ++i) { const int gt = (int)((T - u[i]) >> 31), eq = (int)((T - 1u - u[i]) >> 31) - gt;
            const int room = 1 ^ (int)((unsigned)(need - 1 - er) >> 31);
            nsel += gt | (eq & room); er += eq; } }
    int slot = wave_excl_scan_i(nsel, lane, &tot_sel);
    int* TOK = (int*)(F.ws + WS_TOK); float* VAL = (float*)(F.ws + WS_VAL); bf16_t* SLOT = (bf16_t*)(F.ws + WS_SLOT);
#pragma unroll
    for (int i = 0; i < 64; ++i) { const int sq = 64 * lane + i; const int gt = (int)((T - u[i]) >> 31), eq = (int)((T - 1u - u[i]) >> 31) - gt;
        const int room = 1 ^ (int)((unsigned)(need - 1 - eqr) >> 31); const int sl = gt | (eq & room); eqr += eq;
        if (sl) { TOK[e * 4096 + b * CAP + slot] = b * SEQ + sq; VAL[e * 4096 + b * CAP + slot] = __uint_as_float(u[i]); }
        SLOT[(size_t)(b * SEQ + sq) * 16 + e] = (bf16_t)(sl ? (unsigned)slot : 0xFFFFu); slot += sl;
        asm volatile("" ::: "memory"); }
}
#define FR_SW(s0, s1) {(unsigned)__builtin_amdgcn_readfirstlane((int)s0.x), (unsigned)__builtin_amdgcn_readfirstlane((int)s0.y), (unsigned)__builtin_amdgcn_readfirstlane((int)s0.z), (unsigned)__builtin_amdgcn_readfirstlane((int)s0.w), \
                       (unsigned)__builtin_amdgcn_readfirstlane((int)s1.x), (unsigned)__builtin_amdgcn_readfirstlane((int)s1.y), (unsigned)__builtin_amdgcn_readfirstlane((int)s1.z), (unsigned)__builtin_amdgcn_readfirstlane((int)s1.w)}
__device__ __forceinline__ int fr_issue(Frame& F, int m, u32x4 s0, u32x4 s1, u32x2 (&y0)[4], u32x2 (&y1)[4], u32x2 (&y2)[4], u32x2 (&y3)[4]) {
    const bf16_t* YE = (const bf16_t*)(F.ws + WS_WGU);
    const int b = m >> 12;
    const unsigned sw[8] = FR_SW(s0, s1);
    int k = 0, r0 = 0, r1 = 0, r2 = 0, r3 = 0;
#pragma unroll
    for (int e = 0; e < 16; ++e) { const unsigned sl = (sw[e >> 1] >> (16 * (e & 1))) & 0xffffu;
        if (sl != 0xFFFFu) { const int row = e * 4096 + b * CAP + (int)sl; r0 = k == 0 ? row : r0; r1 = k == 1 ? row : r1; r2 = k == 2 ? row : r2; r3 = k == 3 ? row : r3; ++k; } }
    if (k > 0) { const u32x2* yr = (const u32x2*)(YE + (size_t)r0 * DM) + F.lane;
#pragma unroll
        for (int j = 0; j < 4; ++j) y0[j] = yr[64 * j]; }
    if (k > 1) { const u32x2* yr = (const u32x2*)(YE + (size_t)r1 * DM) + F.lane;
#pragma unroll
        for (int j = 0; j < 4; ++j) y1[j] = yr[64 * j]; }
    if (k > 2) { const u32x2* yr = (const u32x2*)(YE + (size_t)r2 * DM) + F.lane;
#pragma unroll
        for (int j = 0; j < 4; ++j) y2[j] = yr[64 * j]; }
    if (k > 3) { const u32x2* yr = (const u32x2*)(YE + (size_t)r3 * DM) + F.lane;
#pragma unroll
        for (int j = 0; j < 4; ++j) y3[j] = yr[64 * j]; }
    return k;
}
#define FR_ACC(Y) do { _Pragma("unroll") for (int j = 0; j < 4; ++j) { v[j].x += bflo(Y[j].x); v[j].y += bfhi(Y[j].x); v[j].z += bflo(Y[j].y); v[j].w += bfhi(Y[j].y); } } while (0)
__device__ __forceinline__ void fr_accum(f32x4 (&v)[4], const u32x2 (&vin)[4], int k, const u32x2 (&y0)[4], const u32x2 (&y1)[4], const u32x2 (&y2)[4], const u32x2 (&y3)[4]) {
#pragma unroll
    for (int j = 0; j < 4; ++j) v[j] = bf4(vin[j]);
    if (k > 0) FR_ACC(y0);
    if (k > 1) FR_ACC(y1);
    if (k > 2) FR_ACC(y2);
    if (k > 3) FR_ACC(y3);
}
__device__ __forceinline__ void fr_finish(Frame& F, int m, const float (&gf)[16], float* outp, f32x4 (&v)[4], u32x4 s0, u32x4 s1, int k) {
    f32x4* orow = (f32x4*)(outp + (size_t)m * DM) + F.lane;
    if (k > 4) {
        const bf16_t* YE = (const bf16_t*)(F.ws + WS_WGU); const int b = m >> 12; const unsigned sw[8] = FR_SW(s0, s1);
        int kk = 0;
#pragma unroll
        for (int e = 0; e < 16; ++e) { const unsigned sl = (sw[e >> 1] >> (16 * (e & 1))) & 0xffffu;
            if (sl != 0xFFFFu) { if (kk >= 4) { const u32x2* yr = (const u32x2*)(YE + ((size_t)(e * 4096 + b * CAP + (int)sl)) * DM) + F.lane; u32x2 yy[4];
#pragma unroll
                    for (int j = 0; j < 4; ++j) yy[j] = yr[64 * j];
                    FR_ACC(yy); }
                ++kk; } }
    }
    float s = 0.f;
#pragma unroll
    for (int j = 0; j < 4; ++j) s += (v[j].x * v[j].x + v[j].y * v[j].y) + (v[j].z * v[j].z + v[j].w * v[j].w);
    s = wave_sum(s);
    const float rstd = 1.0f / sqrtf(s * (1.0f / DM) + EPS);
#pragma unroll
    for (int j = 0; j < 4; ++j) { f32x4 o; o.x = v[j].x * rstd * gf[4 * j]; o.y = v[j].y * rstd * gf[4 * j + 1]; o.z = v[j].z * rstd * gf[4 * j + 2]; o.w = v[j].w * rstd * gf[4 * j + 3]; orow[64 * j] = o; }
}
#undef FR_ACC
#undef FR_SW

struct Args { const float* in[28]; float* out; unsigned char* ws; int ph_lo, ph_hi; };
constexpr int NPHASE = 11;
__global__ void __launch_bounds__(NTHREADS, 2) mega_fwd(Args args) {
    extern __shared__ __attribute__((aligned(16))) unsigned char lds_raw[];
    Frame F;
    F.lds = (LAS unsigned char*)lds_raw;
    F.tid = threadIdx.x; F.lane = F.tid & 63; F.wave = __builtin_amdgcn_readfirstlane(F.tid >> 6);
    F.G = gridDim.x; { const int bx = blockIdx.x; F.vcu = (F.G % 8 == 0) ? (bx % 8) * (F.G / 8) + bx / 8 : bx; }
#pragma unroll
    for (int i = 0; i < 28; ++i) F.in[i] = args.in[i];
    F.out = args.out; F.ws = args.ws;
    volatile LAS unsigned* MISC = (volatile LAS unsigned*)(F.lds + LDS_MISC);
    if (F.tid < 64) MISC[F.tid] = 0u;
    __syncthreads();
    unsigned* ctl = (unsigned*)(F.ws + WS_CTL);
    XcdBarrier bar = xcd_barrier_post(ctl + 4096, MISC + 8);
    const int lo = args.ph_lo, hi = args.ph_hi;
#ifndef PHASE_MASK
#define PHASE_MASK 0x7ff
#endif
#define IN(k) (((PHASE_MASK >> (k)) & 1) && lo <= (k) && (k) < hi)
#define SEAM(k) do { if (IN(k) && IN((k) + 1)) { xcd_barrier(bar); if (REPS(14) > 1) xcd_barrier(bar); } } while (0)
    const int cblk = blockIdx.x;
    if (IN(0)) phase0(F);
    SEAM(0);
    if (IN(1)) { { ProbG1 p; p.K = DM; p.G = F.G; p.c = cblk; p.xb = (const char*)(F.ws + WS_XB); p.wint = (const char*)(F.ws + WS_WINT);
        p.ax = (bf16_t*)(F.ws + WS_AX); p.gg = (bf16_t*)(F.ws + WS_GG); p.gates = (bf16_t*)F.out; p.hyt = (bf16_t*)(F.ws + WS_HYT); p.rstd = (const float*)(F.ws + WS_RSTD1);
        pg8::gemm_phase(F.lds, p); } }
    SEAM(1);
    if (IN(2)) { for (int rp = 0; rp < REPS(11); ++rp) (void)mixer_a_phase<1>(F);
        for (int rp = 0; rp < REPS(2); ++rp) { bf16_t* ob = (rp + 1 < REPS(2)) ? (bf16_t*)(F.ws + 460 * MiB) : (bf16_t*)(F.ws + WS_HYT);
            if (HYENA_FFT) hyena_phase_fft(F, ob); else hyena_phase(F, ob); } }
    SEAM(2);
    if (IN(3)) { int tdone = 0; for (int rp = 0; rp < REPS(3); ++rp) tdone = mixer_a_phase<2>(F);
        for (int rp = 0; rp < REPS(12); ++rp) ub_transpose_phase(F, rp == 0 ? tdone : 0); }
    SEAM(3);
    if (IN(4)) { { ProbG4 p; p.K = DM; p.G = F.G; p.c = cblk; p.ua = (const char*)(F.ws + WS_XB); p.ub = (const char*)(F.ws + WS_HYT + 64 * MiB);
        p.wa = (const char*)(F.ws + WS_WA); p.wb = (const char*)(F.ws + WS_WB); p.gates = (const bf16_t*)F.out; p.merged = (bf16_t*)(F.ws + WS_AX);
        p.tmp = (f32x4*)(F.ws + WS_GG) + (size_t)cblk * (256 * 256 / 4);
        pg8::gemm_phase(F.lds, p); } }
    SEAM(4);
    if (IN(5)) { { ProbG5 p; p.K = DM; p.G = F.G; p.c = cblk; p.a = (const char*)(F.ws + WS_AX); p.b = (const char*)(F.ws + WS_WO); p.x = F.in[I_X]; p.xmid = (bf16_t*)(F.ws + WS_XMID);
        pg8::gemm_phase(F.lds, p); } }
    SEAM(5);
    if (IN(6)) { for (int rp = 0; rp < REPS(6); ++rp) phase6(F); }
    SEAM(6);
    if (IN(8)) { { ProbG8 p; p.K = DM / 2; p.G = F.G; p.c = cblk; p.h2 = (const char*)(F.ws + WS_H2); p.wgu = (const char*)(F.ws + WS_WGU); p.tok = (const int*)(F.ws + WS_TOK); p.act = F.ws + WS_ACT;
        pg8::gemm_phase(F.lds, p); } }
    SEAM(8);
    if (IN(9)) { { ProbG9 p; p.K = DFF / 2; p.G = F.G; p.c = cblk; p.act = (const char*)(F.ws + WS_ACT); p.wd = (const char*)(F.ws + WS_WD); p.val = (const float*)(F.ws + WS_VAL); p.ye = (bf16_t*)(F.ws + WS_WGU);
        pg8::gemm_phase(F.lds, p); } }
    SEAM(9);
    if (IN(10)) {
        float gf[16];
#pragma unroll
        for (int j = 0; j < 4; ++j) { const f32x4 g4 = *((const f32x4*)F.in[I_GFINAL] + 64 * j + F.lane); gf[4 * j] = g4.x; gf[4 * j + 1] = g4.y; gf[4 * j + 2] = g4.z; gf[4 * j + 3] = g4.w; }
#pragma unroll
    for (int j = 0; j < 16; ++j) asm volatile("" : "+v"(gf[j]));
        const int gw = F.vcu * NWAVES + F.wave, NGW = F.G * NWAVES;
        for (int rp = 0; rp < REPS(10); ++rp) { float* outp = (rp + 1 < REPS(10)) ? (float*)(F.ws + WS_ACT) : F.out;
            const bf16_t* SLOTB = (const bf16_t*)(F.ws + WS_SLOT); const bf16_t* XM = (const bf16_t*)(F.ws + WS_XMID);
            const u32x4 z4 = (u32x4){0u, 0u, 0u, 0u};
            u32x2 cur[4], nxt[4], nn[4]; u32x4 cs0 = z4, cs1 = z4, ns0 = z4, ns1 = z4, nns0, nns1; int ck = 0, nk;
            u32x2 cy0[4], cy1[4], cy2[4], cy3[4], ny0[4], ny1[4], ny2[4], ny3[4];
            if (gw < NT) { row_load_bf(XM, gw, F.lane, cur); cs0 = *(const u32x4*)(SLOTB + (size_t)gw * 16); cs1 = *(const u32x4*)(SLOTB + (size_t)gw * 16 + 8);
                ck = fr_issue(F, gw, cs0, cs1, cy0, cy1, cy2, cy3); }
#pragma unroll
            for (int j = 0; j < 4; ++j) nxt[j] = cur[j];
            if (gw + NGW < NT) { row_load_bf(XM, gw + NGW, F.lane, nxt); ns0 = *(const u32x4*)(SLOTB + (size_t)(gw + NGW) * 16); ns1 = *(const u32x4*)(SLOTB + (size_t)(gw + NGW) * 16 + 8); }
            for (int m = gw; m < NT; m += NGW) {
                f32x4 v[4];
                fr_accum(v, cur, ck, cy0, cy1, cy2, cy3);
                nk = 0;
                if (m + NGW < NT) nk = fr_issue(F, m + NGW, ns0, ns1, ny0, ny1, ny2, ny3);
#pragma unroll
                for (int j = 0; j < 4; ++j) nn[j] = nxt[j];
                nns0 = ns0; nns1 = ns1;
                if (m + 2 * NGW < NT) { row_load_bf(XM, m + 2 * NGW, F.lane, nn); nns0 = *(const u32x4*)(SLOTB + (size_t)(m + 2 * NGW) * 16); nns1 = *(const u32x4*)(SLOTB + (size_t)(m + 2 * NGW) * 16 + 8); }
                fr_finish(F, m, gf, outp, v, cs0, cs1, ck);
#pragma unroll
                for (int j = 0; j < 4; ++j) { cur[j] = nxt[j]; nxt[j] = nn[j]; cy0[j] = ny0[j]; cy1[j] = ny1[j]; cy2[j] = ny2[j]; cy3[j] = ny3[j]; }
                cs0 = ns0; cs1 = ns1; ns0 = nns0; ns1 = nns1; ck = nk; } }
    }
#undef IN
#undef SEAM
}

#ifndef MK_N_LAUNCHES
#define MK_N_LAUNCHES 1
#endif
extern "C" void kernel_launch(void* const* d_in, const int* in_sizes, int n_in, void* d_out, int out_size, void* d_ws, size_t ws_size, hipStream_t stream) {
    static int grid = 0;
    if (grid == 0) {
        if (n_in != 28 || out_size != NT * DM || ws_size < WS_END) { fprintf(stderr, "kernel_launch: unexpected shapes (n_in %d, out %d, ws %zu < %zu)\n", n_in, out_size, ws_size, (size_t)WS_END); grid = -1; return; }
        int dev = 0, cus = 0, per_cu = 0;
        (void)hipGetDevice(&dev); (void)hipDeviceGetAttribute(&cus, hipDeviceAttributeMultiprocessorCount, dev);
        if (hipFuncSetAttribute((const void*)mega_fwd, hipFuncAttributeMaxDynamicSharedMemorySize, LDS_BYTES) != hipSuccess) { fprintf(stderr, "kernel_launch: hipFuncSetAttribute failed\n"); grid = -1; return; }
        if (hipOccupancyMaxActiveBlocksPerMultiprocessor(&per_cu, (const void*)mega_fwd, NTHREADS, LDS_BYTES) != hipSuccess || per_cu < 1) { fprintf(stderr, "kernel_launch: occupancy query says %d\n", per_cu); per_cu = 1; }
        (void)hipGetLastError();
        grid = cus;
    }
    if (grid < 0) return;
    (void)hipMemsetAsync((char*)d_ws + WS_CTL, 0, CTL_BYTES, stream);
    Args a{};
    for (int i = 0; i < 28; ++i) a.in[i] = (const float*)d_in[i];
    a.out = (float*)d_out; a.ws = (unsigned char*)d_ws;
    if (MK_N_LAUNCHES == 1) {
        a.ph_lo = 0; a.ph_hi = NPHASE;
        void* kargs[] = {&a};
        hipError_t e = hipLaunchCooperativeKernel((const void*)mega_fwd, dim3(grid), dim3(NTHREADS), kargs, LDS_BYTES, stream);
        if (e != hipSuccess) fprintf(stderr, "cooperative launch failed: %s (grid %d)\n", hipGetErrorString(e), grid);
    } else {
        for (int p = 0; p < NPHASE; ++p) { a.ph_lo = p; a.ph_hi = p + 1; hipLaunchKernelGGL(mega_fwd, dim3(grid), dim3(NTHREADS), LDS_BYTES, stream, a); }
    }
}
```
